# Optimizing an MI355X kernel written in HIP

```python
import math
import jax, jax.numpy as jnp
from jax import lax
import numpy as np

D_MODEL = 1024
BATCH = 2
SEQ = 8192
DEPTH = 1

A_HEADS = 8
A_HEAD_DIM = 64
A_WIDTH = A_HEADS * A_HEAD_DIM
MOBA_BLOCK = 256
MOBA_TOPK = 3
Q_BLOCK = 128
R_HEADS = 8
R_QK_DIM = 64
R_V_DIM = 128
R_QK_WIDTH = R_HEADS * R_QK_DIM
R_V_WIDTH = R_HEADS * R_V_DIM
R_CHUNK = 128
N_EXPERTS = 256
TOP_K = 8
N_GROUPS = 8
TOPK_GROUPS = 4
EXPERT_FF = 256
SHARED_FF = 256
ROUTED_SCALE = 2.5
EXPERT_ROWS = 128
NORM_EPS = 1e-6
GN_EPS = 1e-6
NEG_INF = -1e30
IN_WIDTHS = (A_WIDTH, A_WIDTH, A_WIDTH, R_QK_WIDTH, R_QK_WIDTH, R_V_WIDTH, R_V_WIDTH, D_MODEL, D_MODEL)
IN_COLS = 3 * A_WIDTH + 2 * R_QK_WIDTH + 2 * R_V_WIDTH + 2 * D_MODEL

kernel_name = 'hybrid_moba_retention_moe_block'


def rmsnorm(x, g):
    xf = x.astype(jnp.float32)
    y = xf * lax.rsqrt(jnp.mean(xf * xf, axis=-1, keepdims=True) + NORM_EPS)
    return (y * g.astype(jnp.float32)).astype(x.dtype)


def alibi_slopes(n):
    return jnp.exp2(-8.0 / n * jnp.arange(1, n + 1, dtype=jnp.float32))


def moba_attention(q, k, v):
    B, S, H, dh = q.shape
    s_pad = -(-S // MOBA_BLOCK) * MOBA_BLOCK
    n_blk = s_pad // MOBA_BLOCK
    n_q = s_pad // Q_BLOCK
    k_sel = min(MOBA_TOPK, n_blk)

    def prep(a):
        a = jnp.transpose(a, (0, 2, 1, 3))
        return jnp.pad(a, ((0, 0), (0, 0), (0, s_pad - S), (0, 0)))

    q, k, v = prep(q), prep(k), prep(v)
    kb = k.reshape(B, H, n_blk, MOBA_BLOCK, dh)
    vb = v.reshape(B, H, n_blk, MOBA_BLOCK, dh)
    k_mean = jnp.mean(kb.astype(jnp.float32), axis=3)
    t_blk = jnp.arange(s_pad) // MOBA_BLOCK
    past = jnp.arange(n_blk)[None, :] < t_blk[:, None]
    gate = jnp.einsum('bhsd,bhnd->bhsn', q.astype(jnp.float32), k_mean)
    gate = jnp.where(past, gate, NEG_INF)
    _, sel = lax.top_k(gate, k_sel)
    valid = jnp.arange(k_sel)[None, :] < t_blk[:, None]
    scale = dh ** -0.5
    slopes = alibi_slopes(H)
    bi = jnp.arange(B)[:, None, None, None]
    hi = jnp.arange(H)[None, :, None, None]
    offs = jnp.arange(MOBA_BLOCK)

    def to_blocks(a):
        a = a.reshape(B, H, n_q, Q_BLOCK, *a.shape[3:])
        return jnp.moveaxis(a, 2, 0)

    xs = (to_blocks(q), to_blocks(sel), valid.reshape(n_q, Q_BLOCK, k_sel), jnp.arange(n_q))

    def one_block(args):
        qb, sb, vmask, qi = args
        t = qi * Q_BLOCK + jnp.arange(Q_BLOCK)
        own = (qi * Q_BLOCK) // MOBA_BLOCK
        k_g = kb[bi, hi, sb]
        v_g = vb[bi, hi, sb]
        s_g = jnp.einsum('bhqd,bhqnkd->bhqnk', qb, k_g).astype(jnp.float32) * scale
        pos_g = sb[..., None] * MOBA_BLOCK + offs
        dist_g = (t[None, None, :, None, None] - pos_g).astype(jnp.float32)
        s_g = s_g - slopes[None, :, None, None, None] * dist_g
        s_g = jnp.where(vmask[None, None, :, :, None], s_g, NEG_INF)
        k_o = lax.dynamic_index_in_dim(kb, own, axis=2, keepdims=False)
        v_o = lax.dynamic_index_in_dim(vb, own, axis=2, keepdims=False)
        pos_o = own * MOBA_BLOCK + offs
        dist_o = (t[:, None] - pos_o[None, :]).astype(jnp.float32)
        s_o = jnp.einsum('bhqd,bhkd->bhqk', qb, k_o).astype(jnp.float32) * scale
        s_o = s_o - slopes[None, :, None, None] * dist_o
        s_o = jnp.where(dist_o >= 0, s_o, NEG_INF)
        s_all = jnp.concatenate([s_g.reshape(B, H, Q_BLOCK, k_sel * MOBA_BLOCK), s_o], axis=-1)
        p = jax.nn.softmax(s_all, axis=-1).astype(v.dtype)
        p_g = p[..., :k_sel * MOBA_BLOCK].reshape(B, H, Q_BLOCK, k_sel, MOBA_BLOCK)
        p_o = p[..., k_sel * MOBA_BLOCK:]
        return (jnp.einsum('bhqnk,bhqnkd->bhqd', p_g, v_g)
                + jnp.einsum('bhqk,bhkd->bhqd', p_o, v_o))

    o = lax.map(one_block, xs)
    o = jnp.moveaxis(o, 0, 2).reshape(B, H, s_pad, dh)[:, :, :S]
    return jnp.transpose(o, (0, 2, 1, 3)).reshape(B, S, H * dh)


def retention(q, k, v):
    B, S, H, dk = q.shape
    dv = v.shape[-1]
    n_c = S // R_CHUNK

    def chunks(a):
        a = a.astype(jnp.float32).reshape(B, n_c, R_CHUNK, H, a.shape[-1])
        return jnp.transpose(a, (1, 0, 3, 2, 4))

    qc, kc, vc = chunks(q), chunks(k * (dk ** -0.5)), chunks(v)
    log_g = jnp.log(1.0 - jnp.exp2(-5.0 - jnp.arange(H, dtype=jnp.float32)))
    n = jnp.arange(R_CHUNK, dtype=jnp.float32)
    diff = n[:, None] - n[None, :]
    decay = jnp.where(diff >= 0, jnp.exp(jnp.maximum(diff, 0.0) * log_g[:, None, None]), 0.0)
    q_decay = jnp.exp((n + 1.0) * log_g[:, None])
    k_decay = jnp.exp((R_CHUNK - 1.0 - n) * log_g[:, None])
    chunk_decay = jnp.exp(R_CHUNK * log_g)

    def step(state, inp):
        qi, ki, vi = inp
        inner = jnp.einsum('bhnd,bhmd->bhnm', qi, ki) * decay
        out = (jnp.einsum('bhnm,bhme->bhne', inner, vi)
               + jnp.einsum('bhnd,bhde->bhne', qi, state) * q_decay[None, :, :, None])
        state = (chunk_decay[None, :, None, None] * state
                 + jnp.einsum('bhmd,bhme->bhde', ki * k_decay[None, :, :, None], vi))
        return state, out

    state0 = jnp.zeros((B, H, dk, dv), jnp.float32)
    _, o = lax.scan(step, state0, (qc, kc, vc))
    return jnp.transpose(o, (1, 0, 3, 2, 4)).reshape(B, S, H, dv)


def head_groupnorm(y):
    mu = jnp.mean(y, axis=-1, keepdims=True)
    var = jnp.mean(jnp.square(y - mu), axis=-1, keepdims=True)
    return (y - mu) * lax.rsqrt(var + GN_EPS)


def token_mixer(h, w_in, w_pa, w_pr, w_out):
    B, S, _ = h.shape
    proj = h @ w_in
    cuts = np.cumsum(IN_WIDTHS)[:-1].tolist()
    qa, ka, va, qr, kr, vr, gr, ga, gt = jnp.split(proj, cuts, axis=-1)
    y_a = moba_attention(qa.reshape(B, S, A_HEADS, A_HEAD_DIM),
                         ka.reshape(B, S, A_HEADS, A_HEAD_DIM),
                         va.reshape(B, S, A_HEADS, A_HEAD_DIM)).astype(h.dtype)
    y_r = retention(qr.reshape(B, S, R_HEADS, R_QK_DIM),
                    kr.reshape(B, S, R_HEADS, R_QK_DIM),
                    vr.reshape(B, S, R_HEADS, R_V_DIM))
    y_r = head_groupnorm(y_r).reshape(B, S, R_V_WIDTH).astype(h.dtype) * jax.nn.silu(gr)
    merged = jax.nn.sigmoid(ga) * (y_a @ w_pa) + jax.nn.sigmoid(gt) * (y_r @ w_pr)
    return merged @ w_out


def moe_ffn(h, w_router, router_bias, w1, w3, w2, ws1, ws3, ws2):
    T, D = h.shape
    scores = jax.nn.sigmoid((h @ w_router).astype(jnp.float32))
    choice = scores + router_bias.astype(jnp.float32)
    grouped = choice.reshape(T, N_GROUPS, N_EXPERTS // N_GROUPS)
    group_score = jnp.sum(lax.top_k(grouped, 2)[0], axis=-1)
    _, gidx = lax.top_k(group_score, TOPK_GROUPS)
    gmask = jnp.any(gidx[..., None] == jnp.arange(N_GROUPS), axis=1)
    emask = jnp.repeat(gmask, N_EXPERTS // N_GROUPS, axis=1)
    _, eidx = lax.top_k(jnp.where(emask, choice, NEG_INF), TOP_K)
    wts = jnp.take_along_axis(scores, eidx, axis=1)
    wts = wts / (jnp.sum(wts, axis=-1, keepdims=True) + 1e-20) * ROUTED_SCALE

    n_assign = T * TOP_K
    flat_e = eidx.reshape(-1)
    flat_tok = jnp.repeat(jnp.arange(T, dtype=jnp.int32), TOP_K)
    flat_w = wts.reshape(-1)
    order = jnp.argsort(flat_e)
    se, st, sw = flat_e[order], flat_tok[order], flat_w[order]
    counts = jnp.bincount(flat_e, length=N_EXPERTS)
    padded = (counts + EXPERT_ROWS - 1) // EXPERT_ROWS * EXPERT_ROWS
    pstart = jnp.cumsum(padded) - padded
    cstart = jnp.cumsum(counts) - counts
    pos = pstart[se] + (jnp.arange(n_assign) - cstart[se])
    n_rblk = -(-n_assign // EXPERT_ROWS) + N_EXPERTS
    pad_tok = jnp.zeros((n_rblk * EXPERT_ROWS,), jnp.int32).at[pos].set(st)
    pad_w = jnp.zeros((n_rblk * EXPERT_ROWS,), jnp.float32).at[pos].set(sw)
    blk_end = jnp.cumsum(padded // EXPERT_ROWS)
    blk_e = jnp.minimum(jnp.searchsorted(blk_end, jnp.arange(n_rblk), side='right'), N_EXPERTS - 1)

    def step(acc, inp):
        e, tok, wt = inp
        xb = h[tok]
        o = (jax.nn.silu(xb @ w1[e]) * (xb @ w3[e])) @ w2[e]
        return acc.at[tok].add(o.astype(jnp.float32) * wt[:, None]), None

    acc, _ = lax.scan(step, jnp.zeros((T, D), jnp.float32),
                      (blk_e, pad_tok.reshape(n_rblk, EXPERT_ROWS), pad_w.reshape(n_rblk, EXPERT_ROWS)))
    shared = (jax.nn.silu(h @ ws1) * (h @ ws3)) @ ws2
    return acc.astype(h.dtype) + shared


def setup_inputs(seed: int = 0) -> dict:
    key = jax.random.key(seed)
    ks = jax.random.split(key, 20)
    L, D = DEPTH, D_MODEL

    def nrm(k, shape, scale):
        return jax.random.normal(k, shape, jnp.float32) * scale

    return {
        'x': nrm(ks[0], (BATCH, SEQ, D), 1.0),
        'c': nrm(ks[1], (BATCH, D), 1.0),
        'w_ada': nrm(ks[2], (L, D, 6 * D), 0.5 * D ** -0.5),
        'b_ada': nrm(ks[3], (L, 6 * D), 0.02),
        'g_mix': 1.0 + nrm(ks[4], (L, D), 0.02),
        'w_in': nrm(ks[5], (L, D, IN_COLS), D ** -0.5),
        'w_pa': nrm(ks[6], (L, A_WIDTH, D), A_WIDTH ** -0.5),
        'w_pr': nrm(ks[7], (L, R_V_WIDTH, D), R_V_WIDTH ** -0.5),
        'w_out': nrm(ks[8], (L, D, D), D ** -0.5),
        'g_ffn': 1.0 + nrm(ks[9], (L, D), 0.02),
        'w_router': nrm(ks[10], (L, D, N_EXPERTS), D ** -0.5),
        'router_bias': nrm(ks[11], (L, N_EXPERTS), 0.01),
        'w1': nrm(ks[12], (L, N_EXPERTS, D, EXPERT_FF), D ** -0.5),
        'w3': nrm(ks[13], (L, N_EXPERTS, D, EXPERT_FF), D ** -0.5),
        'w2': nrm(ks[14], (L, N_EXPERTS, EXPERT_FF, D), EXPERT_FF ** -0.5),
        'ws1': nrm(ks[15], (L, D, SHARED_FF), D ** -0.5),
        'ws3': nrm(ks[16], (L, D, SHARED_FF), D ** -0.5),
        'ws2': nrm(ks[17], (L, SHARED_FF, D), SHARED_FF ** -0.5),
        'g_final': 1.0 + nrm(ks[18], (D,), 0.02),
    }


def reference(x, c, w_ada, b_ada, g_mix, w_in, w_pa, w_pr, w_out, g_ffn, w_router,
              router_bias, w1, w3, w2, ws1, ws3, ws2, g_final):
    B, S, D = x.shape
    for l in range(DEPTH):
        mod = (jax.nn.silu(c) @ w_ada[l] + b_ada[l])[:, None, :]
        sh1, sc1, gt1, sh2, sc2, gt2 = jnp.split(mod, 6, axis=-1)
        h = rmsnorm(x, g_mix[l]) * (1.0 + sc1) + sh1
        x = x + gt1 * token_mixer(h, w_in[l], w_pa[l], w_pr[l], w_out[l])
        h = rmsnorm(x, g_ffn[l]) * (1.0 + sc2) + sh2
        y = moe_ffn(h.reshape(B * S, D), w_router[l], router_bias[l], w1[l], w3[l], w2[l],
                    ws1[l], ws3[l], ws2[l])
        x = x + gt2 * y.reshape(B, S, D)
    return rmsnorm(x, g_final)
```

```cpp
#include <hip/hip_runtime.h>
#include <stdint.h>
#include <stdio.h>
#include <hip/hip_cooperative_groups.h>
namespace cg = cooperative_groups;

typedef unsigned short u16;
typedef short bf16x8 __attribute__((ext_vector_type(8)));
typedef short bf16x4 __attribute__((ext_vector_type(4)));
typedef float f32x4 __attribute__((ext_vector_type(4)));
#define LAS __attribute__((address_space(3)))

constexpr int NT = 512;
constexpr int T = 16384, D = 1024, SEQ = 8192, NB = 2;
constexpr int NPROJ = 6656;
constexpr int C_QA = 0, C_KA = 512, C_VA = 1024, C_QR = 1536, C_KR = 2048, C_VR = 2560, C_GR = 3584, C_GA = 4608, C_GT = 5632;
constexpr int NE = 256, TOPK = 8, FF = 256;
constexpr int NSLOT = T * TOPK + T;

constexpr size_t al256(size_t x) { return (x + 255) & ~(size_t)255; }
constexpr size_t WS_CTL = 0;
constexpr size_t CTL_BYTES = 4096 + 16384 + 32768;
constexpr int ECNT_STRIDE = 32;
constexpr size_t WS_MOD = WS_CTL + CTL_BYTES;
constexpr size_t WS_KMEAN = WS_MOD + al256(2 * 6144 * 4);
constexpr size_t WS_WTIN = WS_KMEAN + al256(2 * 8 * 32 * 64 * 4);
constexpr size_t WS_WTPA = WS_WTIN + (size_t)NPROJ * 1024 * 2;
constexpr size_t WS_WTPR = WS_WTPA + (size_t)1024 * 512 * 2;
constexpr size_t WS_WTOUT = WS_WTPR + (size_t)1024 * 1024 * 2;
constexpr size_t WS_WTRT = WS_WTOUT + (size_t)1024 * 1024 * 2;
constexpr size_t WS_WTS13 = WS_WTRT + (size_t)256 * 1024 * 2;
constexpr size_t WS_WTS2 = WS_WTS13 + (size_t)512 * 1024 * 2;
constexpr size_t WS_GSH = WS_WTS2 + (size_t)1024 * 256 * 2;
constexpr size_t WS_GBUF = WS_GSH + (size_t)T * 256 * 2;
constexpr size_t WS_X1 = WS_GBUF + (size_t)512 * 131072;
constexpr size_t WS_H = WS_X1 + (size_t)T * D * 4;
constexpr size_t WS_H2 = WS_H + (size_t)T * D * 2;
constexpr size_t WS_ALIST = WS_H2 + (size_t)T * D * 2;
constexpr int ALIST_PER_BH = 256 * 496;
constexpr size_t WS_ELIST = WS_ALIST + (size_t)16 * ALIST_PER_BH * 4;
constexpr size_t WS_WTS = WS_ELIST + (size_t)NE * T * 4;
constexpr size_t WS_LOGIT = WS_WTS + (size_t)T * 8 * 4;
constexpr size_t WS_R = WS_LOGIT + (size_t)T * 256 * 4;
constexpr size_t WS_PROJ = WS_R;
constexpr size_t WS_OPART = WS_PROJ + (size_t)T * NPROJ * 2;
constexpr size_t WS_ML = WS_OPART + (size_t)T * 8 * 4 * 64 * 2;
constexpr size_t WS_KV = WS_ML + (size_t)T * 8 * 4 * 2 * 4;
constexpr size_t WS_SPREV = WS_KV + (size_t)16 * 64 * 8192 * 4;
constexpr size_t WS_YA = WS_SPREV + (size_t)16 * 64 * 8192 * 2;
constexpr size_t WS_YR = WS_YA + (size_t)T * 512 * 2;
constexpr size_t WS_MERGED = WS_YR + (size_t)T * 1024 * 2;
constexpr size_t WS_END_MIX = WS_MERGED + (size_t)T * 1024 * 2;
constexpr size_t WS_OSLOT = WS_END_MIX;
constexpr size_t WS_END_MOE = WS_OSLOT + (size_t)NSLOT * 1024 * 2;
constexpr size_t WS_END = WS_END_MIX > WS_END_MOE ? WS_END_MIX : WS_END_MOE;

struct Params {
    const float *x, *c, *w_ada, *b_ada, *g_mix, *w_in, *w_pa, *w_pr, *w_out, *g_ffn, *w_router, *router_bias, *w1, *w3, *w2, *ws1, *ws3, *ws2, *g_final;
    float* out;
    unsigned char* ws;
};

__device__ __forceinline__ float bf2f(u16 b) { return __uint_as_float(((unsigned)b) << 16); }
__device__ __forceinline__ u16 f2bf(float f) { unsigned u = __float_as_uint(f); u += 0x7fffu + ((u >> 16) & 1u); return (u16)(u >> 16); }
__device__ __forceinline__ unsigned pk2(float lo, float hi) { unsigned r; asm("v_cvt_pk_bf16_f32 %0, %1, %2" : "=v"(r) : "v"(lo), "v"(hi)); return r; }
__device__ __forceinline__ float sigmoidf_(float x) { return __builtin_amdgcn_rcpf(1.0f + __builtin_amdgcn_exp2f(x * -1.44269504f)); }
__device__ __forceinline__ float siluf_(float x) { return x * __builtin_amdgcn_rcpf(1.0f + __builtin_amdgcn_exp2f(x * -1.44269504f)); }
__device__ __forceinline__ float wave_sum(float v) {
#pragma unroll
    for (int o = 32; o >= 1; o >>= 1) v += __shfl_xor(v, o);
    return v;
}
__device__ __forceinline__ int opaque_tid() { int t = threadIdx.x; asm volatile("" : "+v"(t)); return t; }
#define TR_READ_ASM(dst, addr, OFF) asm volatile("ds_read_b64_tr_b16 %0, %1 offset:%2" : "=v"(dst) : "v"(addr), "i"(OFF) : "memory")
__device__ __forceinline__ int swz_off(int row, int piece) { return row * 128 + ((piece ^ (row & 7)) << 4); }

constexpr int BM = 128, BN = 256, BK = 64;
constexpr int A_TILE_BYTES = BM * BK * 2, B_TILE_BYTES = BN * BK * 2, STAGE_BYTES = A_TILE_BYTES + B_TILE_BYTES;

template <bool A_LDS>
__device__ __forceinline__ void gemm_compute(f32x4 (&acc)[4][4], const unsigned char* As, const unsigned char* Bs, int wm, int wn, int fr, int fq) {
#pragma unroll
    for (int ks = 0; ks < 2; ++ks) {
        bf16x8 af[4], bfr[4];
#pragma unroll
        for (int mi = 0; mi < 4; ++mi) af[mi] = *(const bf16x8*)(As + swz_off(wm * 64 + mi * 16 + fr, ks * 4 + fq));
#pragma unroll
        for (int ni = 0; ni < 4; ++ni) bfr[ni] = *(const bf16x8*)(Bs + swz_off(wn * 64 + ni * 16 + fr, ks * 4 + fq));
#pragma unroll
        for (int mi = 0; mi < 4; ++mi)
#pragma unroll
            for (int ni = 0; ni < 4; ++ni) acc[mi][ni] = __builtin_amdgcn_mfma_f32_16x16x32_bf16(bfr[ni], af[mi], acc[mi][ni], 0, 0, 0);
    }
}

template <int NBUF, bool A_LDS, class AL, class BL>
__device__ __forceinline__ void gemm_loop(f32x4 (&acc)[4][4], const AL& al, const BL& bl, int nk, unsigned char* smem, const unsigned char* a_lds) {
    const int tid = opaque_tid(), lane = tid & 63, wid = tid >> 6;
    const int wm = wid & 1, wn = wid >> 1, fr = lane & 15, fq = lane >> 4;
    const int lr = tid >> 3, lc = tid & 7;
    constexpr int SB = A_LDS ? B_TILE_BYTES : STAGE_BYTES;
    constexpr int BOFF = A_LDS ? 0 : A_TILE_BYTES;
    uint4 ra[2], rb[4];
    if (!A_LDS) {
#pragma unroll
        for (int i = 0; i < 2; ++i) ra[i] = al(lr + 64 * i, 0, lc);
    }
#pragma unroll
    for (int i = 0; i < 4; ++i) rb[i] = bl(lr + 64 * i, 0, lc);
    if (NBUF == 2) {
        {
            unsigned char* st = smem;
            if (!A_LDS) {
#pragma unroll
                for (int i = 0; i < 2; ++i) *(uint4*)(st + swz_off(lr + 64 * i, lc)) = ra[i];
            }
#pragma unroll
            for (int i = 0; i < 4; ++i) *(uint4*)(st + BOFF + swz_off(lr + 64 * i, lc)) = rb[i];
        }
        __syncthreads();
        for (int kt = 0; kt < nk; ++kt) {
            unsigned char* cur = smem + (kt & 1) * SB;
            unsigned char* nxt = smem + ((kt + 1) & 1) * SB;
            const bool more = (kt + 1 < nk);
            if (more) {
                if (!A_LDS) {
#pragma unroll
                    for (int i = 0; i < 2; ++i) ra[i] = al(lr + 64 * i, kt + 1, lc);
                }
#pragma unroll
                for (int i = 0; i < 4; ++i) rb[i] = bl(lr + 64 * i, kt + 1, lc);
            }
            gemm_compute<A_LDS>(acc, A_LDS ? (a_lds + kt * A_TILE_BYTES) : cur, cur + BOFF, wm, wn, fr, fq);
            if (more) {
                if (!A_LDS) {
#pragma unroll
                    for (int i = 0; i < 2; ++i) *(uint4*)(nxt + swz_off(lr + 64 * i, lc)) = ra[i];
                }
#pragma unroll
                for (int i = 0; i < 4; ++i) *(uint4*)(nxt + BOFF + swz_off(lr + 64 * i, lc)) = rb[i];
            }
            __syncthreads();
        }
    } else {
        for (int kt = 0; kt < nk; ++kt) {
            if (kt > 0) __syncthreads();
            if (!A_LDS) {
#pragma unroll
                for (int i = 0; i < 2; ++i) *(uint4*)(smem + swz_off(lr + 64 * i, lc)) = ra[i];
            }
#pragma unroll
            for (int i = 0; i < 4; ++i) *(uint4*)(smem + BOFF + swz_off(lr + 64 * i, lc)) = rb[i];
            __syncthreads();
            if (kt + 1 < nk) {
                if (!A_LDS) {
#pragma unroll
                    for (int i = 0; i < 2; ++i) ra[i] = al(lr + 64 * i, kt + 1, lc);
                }
#pragma unroll
                for (int i = 0; i < 4; ++i) rb[i] = bl(lr + 64 * i, kt + 1, lc);
            }
            gemm_compute<A_LDS>(acc, A_LDS ? (a_lds + kt * A_TILE_BYTES) : smem, smem + BOFF, wm, wn, fr, fq);
        }
        __syncthreads();
    }
}

struct PlainLoader {
    const u16* base; size_t ld;
    __device__ __forceinline__ uint4 operator()(int r, int kt, int piece) const { return *(const uint4*)(base + (size_t)r * ld + kt * 64 + piece * 8); }
};
struct GatherLoader {
    const u16* base; size_t ld; const int* rows;
    __device__ __forceinline__ uint4 operator()(int r, int kt, int piece) const { return *(const uint4*)(base + (size_t)rows[r] * ld + kt * 64 + piece * 8); }
};
__device__ __forceinline__ void zero_acc(f32x4 (&acc)[4][4]) {
#pragma unroll
    for (int a = 0; a < 4; ++a)
#pragma unroll
        for (int b = 0; b < 4; ++b) acc[a][b] = (f32x4){0.f, 0.f, 0.f, 0.f};
}

__device__ __forceinline__ bf16x8 tr_frag2(const unsigned char* lbase, int off0, int off1) {
    const bf16x4 a = __builtin_amdgcn_ds_read_tr16_b64_v4i16((LAS bf16x4*)(lbase + off0));
    const bf16x4 b = __builtin_amdgcn_ds_read_tr16_b64_v4i16((LAS bf16x4*)(lbase + off1));
    return (bf16x8){a[0], a[1], a[2], a[3], b[0], b[1], b[2], b[3]};
}
__device__ __forceinline__ const unsigned char* tr_lane_base(const unsigned char* tile, int pitch, int row_of_group, int lane) {
    const int i = lane & 15;
    return tile + (row_of_group + (i >> 2)) * pitch + (i & 3) * 8;
}

constexpr int WB_PITCH = 544, WB_TILE_BYTES = 64 * WB_PITCH;

template <bool A_LDS>
__device__ __forceinline__ void gemm_compute_w(f32x4 (&acc)[4][4], const unsigned char* As, const unsigned char* Bs, int wm, int wn, int fr, int fq, int lane) {
    const int i = lane & 15;
    const unsigned char* bb = Bs + (8 * fq + (i >> 2)) * WB_PITCH + ((wn ^ (fq & 1)) * 128) + (i & 3) * 8;
#pragma unroll
    for (int ks = 0; ks < 2; ++ks) {
        bf16x8 af[4], bfr[4];
#pragma unroll
        for (int mi = 0; mi < 4; ++mi) af[mi] = *(const bf16x8*)(As + swz_off(wm * 64 + mi * 16 + fr, ks * 4 + fq));
#pragma unroll
        for (int ni = 0; ni < 4; ++ni) bfr[ni] = tr_frag2(bb, ks * 32 * WB_PITCH + ni * 32, (ks * 32 + 4) * WB_PITCH + ni * 32);
#pragma unroll
        for (int mi = 0; mi < 4; ++mi)
#pragma unroll
            for (int ni = 0; ni < 4; ++ni) acc[mi][ni] = __builtin_amdgcn_mfma_f32_16x16x32_bf16(bfr[ni], af[mi], acc[mi][ni], 0, 0, 0);
    }
}

struct WLoader { const float* base; int ld; __device__ __forceinline__ float4 operator()(int k) const { return *(const float4*)(base + (size_t)k * ld); } };
template <int NBUF, bool A_LDS, class AL, class WL>
__device__ __forceinline__ void gemm_loop_w(f32x4 (&acc)[4][4], const AL& al, const WL& wl, int nk, unsigned char* smem, const unsigned char* a_lds) {
    const int tid = opaque_tid(), lane = tid & 63, wid = tid >> 6;
    const int wm = wid & 1, wn = wid >> 1, fr = lane & 15, fq = lane >> 4;
    const int lr = tid >> 3, lc = tid & 7;
    const int n4 = tid & 63, kr = tid >> 6;
    constexpr int SB = A_LDS ? WB_TILE_BYTES : (A_TILE_BYTES + WB_TILE_BYTES);
    constexpr int BOFF = A_LDS ? 0 : A_TILE_BYTES;
    uint4 ra[2]; float4 rw[8];
    auto load = [&](int kt) {
        if constexpr (!A_LDS) {
#pragma unroll
            for (int i = 0; i < 2; ++i) ra[i] = al(lr + 64 * i, kt, lc);
        }
#pragma unroll
        for (int i = 0; i < 8; ++i) rw[i] = wl(kt * 64 + kr + 8 * i);
    };
    auto store = [&](unsigned char* st) {
        if constexpr (!A_LDS) {
#pragma unroll
            for (int i = 0; i < 2; ++i) *(uint4*)(st + swz_off(lr + 64 * i, lc)) = ra[i];
        }
#pragma unroll
        for (int i = 0; i < 8; ++i) {
            const int k = kr + 8 * i;
            uint2 w; w.x = pk2(rw[i].x, rw[i].y); w.y = pk2(rw[i].z, rw[i].w);
            *(uint2*)(st + BOFF + k * WB_PITCH + ((n4 * 8) ^ ((i & 1) << 7))) = w;
        }
    };
    load(0);
    if (NBUF == 2) {
        store(smem);
        __syncthreads();
        for (int kt = 0; kt < nk; ++kt) {
            unsigned char* cur = smem + (kt & 1) * SB;
            unsigned char* nxt = smem + ((kt + 1) & 1) * SB;
            const bool more = (kt + 1 < nk);
            if (more) load(kt + 1);
            gemm_compute_w<A_LDS>(acc, A_LDS ? (a_lds + kt * A_TILE_BYTES) : cur, cur + BOFF, wm, wn, fr, fq, lane);
            if (more) store(nxt);
            __syncthreads();
        }
    } else {
        for (int kt = 0; kt < nk; ++kt) {
            if (kt > 0) __syncthreads();
            store(smem);
            __syncthreads();
            if (kt + 1 < nk) load(kt + 1);
            gemm_compute_w<A_LDS>(acc, A_LDS ? (a_lds + kt * A_TILE_BYTES) : smem, smem + BOFF, wm, wn, fr, fq, lane);
        }
        __syncthreads();
    }
}


namespace pg8 {
#define PG8_LAS __attribute__((address_space(3)))
typedef unsigned short bf16_t;
typedef short bf16x8 __attribute__((ext_vector_type(8)));
typedef float f32x4 __attribute__((ext_vector_type(4)));
typedef unsigned u32x4 __attribute__((ext_vector_type(4)));
constexpr int BM = 256, BK = 64, HALF = 128, HTB = HALF * BK * 2  , STAGE_BYTES = 8 * HTB, NXCD = 8, WGM = 8;

__host__ __device__ __forceinline__ int lds_byte(int r, int c) { const int st = (r >> 4) * 2 + (c >> 5), rr = r & 15, cc = c & 31, ob = rr * 64 + cc * 2; return st * 1024 + (ob ^ (((ob >> 9) & 1) << 5)); }
__host__ __device__ __forceinline__ void stage_rc(int b, int& R, int& C) { const int st = b / 1024, sb = b % 1024, swz = sb ^ (((sb >> 9) & 1) << 5); R = (st >> 1) * 16 + swz / 64; C = (st & 1) * 32 + (swz % 64) / 2; }
__host__ __device__ __forceinline__ int perm32(int rho) { const int n = rho >> 4, i = rho & 15; return 8 * (i >> 2) + 4 * n + (i & 3); }

struct Unit { int pm, pn; };
struct Gemm { const bf16_t* A; const bf16_t* Bt; int M, N, K; };

struct StaticOrder {
    int nM, nN, nwg, G, c;
    __host__ __device__ void init(int M, int N, int G_, int c_) { nM = M / BM; nN = N / BM; nwg = nM * nN; G = G_; c = c_; }
    __host__ __device__ bool next(int i, Unit& u) const {
        const long L = (long)i * G + c; if (L >= nwg) return false;
        int wgid = (int)L; { const int q = nwg / NXCD, r = nwg % NXCD, xcd = wgid % NXCD, off = wgid / NXCD; wgid = (xcd < r ? xcd * (q + 1) : r * (q + 1) + (xcd - r) * q) + off; }
        const int nig = WGM * nN, gid = wgid / nig, fm = gid * WGM, gsz = (nM - fm) < WGM ? (nM - fm) : WGM;
        u.pm = fm + ((wgid % nig) % gsz); u.pn = (wgid % nig) / gsz; return true;
    }
    __device__ __forceinline__ void a_ready(const Unit&) const {}
    __device__ __forceinline__ void done(const Unit&) const {}
};

__device__ __forceinline__ unsigned cvt_pk_bf16(float lo, float hi) { unsigned r; asm volatile("v_cvt_pk_bf16_f32 %0, %1, %2" : "=v"(r) : "v"(lo), "v"(hi)); return r; }
template <class Epi, class Sched, bool ALIGN_EPI = false, bool SP2 = false>
__device__ __forceinline__ void gemm_phase(PG8_LAS unsigned char* lds, const Gemm g, const Sched& S, const Epi& E) {
    const int tid = opaque_tid(), wid = __builtin_amdgcn_readfirstlane(tid >> 6), lane = tid & 63, wr = wid >> 2, wc = wid & 3, fr = lane & 15, fq = lane >> 4;
    const int K = g.K, nt = K / BK;
    unsigned voffA[2], voffB[2];
#pragma unroll
    for (int i = 0; i < 2; ++i) { int R, C; stage_rc(tid * 16 + i * 8192, R, C); const int Rb = Epi::PERM ? ((R & ~31) + perm32(R & 31)) : R;
        voffA[i] = (unsigned)(R * K + C) * 2u; voffB[i] = (unsigned)(Rb * K + C) * 2u; }
    const size_t kstep = (size_t)(BK * 2);
    const size_t hstep = (size_t)HALF * K * 2;
    const size_t tstep = 2 * hstep;
    const unsigned ldsw = (unsigned)wid * 1024u;
    const int aoff = lds_byte(wr * 64 + fr, fq * 8), boff = lds_byte(wc * 32 + fr, fq * 8);
#define PG8_SA(b, h) (((b) * 2 + (h)) * HTB)
#define PG8_SB(b, h) ((4 + (b) * 2 + (h)) * HTB)
#define PG8_STAGE(bufoff, gbase, voff) do { _Pragma("unroll") for (int _i = 0; _i < 2; ++_i) \
        __builtin_amdgcn_global_load_lds((const unsigned*)((const char*)(gbase) + (voff)[_i]), (PG8_LAS unsigned*)(lds + (bufoff) + ldsw + _i * 8192), 16, 0, 0); } while (0)
#define PG8_LDA(dst, b, h) do { _Pragma("unroll") for (int m = 0; m < 4; ++m) _Pragma("unroll") for (int k = 0; k < 2; ++k) dst[m][k] = *(const PG8_LAS bf16x8*)(lds + PG8_SA(b, h) + aoff + m * 2048 + k * 1024); } while (0)
#define PG8_LDB(dst, b, h) do { _Pragma("unroll") for (int n = 0; n < 2; ++n) _Pragma("unroll") for (int k = 0; k < 2; ++k) dst[n][k] = *(const PG8_LAS bf16x8*)(lds + PG8_SB(b, h) + boff + n * 2048 + k * 1024); } while (0)
#define PG8_MMA(ai, bj, At, Bt) do { __builtin_amdgcn_s_setprio(1); _Pragma("unroll") for (int m = 0; m < 4; ++m) _Pragma("unroll") for (int n = 0; n < 2; ++n) _Pragma("unroll") for (int k = 0; k < 2; ++k) \
        acc[ai][bj][m][n] = __builtin_amdgcn_mfma_f32_16x16x32_bf16(Bt[n][k], At[m][k], acc[ai][bj][m][n], 0, 0, 0); __builtin_amdgcn_s_setprio(0); } while (0)
#define PG8_WAIT_V(n) asm volatile("s_waitcnt vmcnt(" #n ")" ::: "memory")
#define PG8_WAIT_L(n) asm volatile("s_waitcnt lgkmcnt(" #n ")" ::: "memory")
#define PG8_BAR __builtin_amdgcn_s_barrier()
#define PG8_SCHED __builtin_amdgcn_sched_barrier(0)
    Unit cur, nxt; int ui = 0;
    if (!S.next(0, cur)) return;
    f32x4 acc[2][2][4][2];
#pragma unroll
    for (int a = 0; a < 2; ++a)
#pragma unroll
        for (int b = 0; b < 2; ++b)
#pragma unroll
            for (int m = 0; m < 4; ++m)
#pragma unroll
                for (int n = 0; n < 2; ++n) acc[a][b][m][n] = (f32x4){0.f, 0.f, 0.f, 0.f};
    bf16x8 At[4][2], B0[2][2], B1[2][2];
    const char* cA = (const char*)g.A + (size_t)cur.pm * tstep; const char* cB = (const char*)g.Bt + (size_t)cur.pn * tstep;
    S.a_ready(cur);
    if constexpr (SP2) {
        PG8_STAGE(PG8_SB(0, 0), cB, voffB); PG8_STAGE(PG8_SB(0, 1), cB + hstep, voffB); PG8_STAGE(PG8_SA(0, 0), cA, voffA); PG8_STAGE(PG8_SA(0, 1), cA + hstep, voffA);
        if (wr == 1) PG8_BAR;
        PG8_WAIT_V(2); PG8_BAR;
        PG8_STAGE(PG8_SB(1, 0), cB + kstep, voffB); PG8_STAGE(PG8_SA(1, 0), cA + kstep, voffA); PG8_STAGE(PG8_SB(1, 1), cB + hstep + kstep, voffB);
        PG8_WAIT_V(6); PG8_BAR;
    } else {
        PG8_STAGE(PG8_SB(0, 0), cB, voffB); PG8_STAGE(PG8_SA(0, 0), cA, voffA); PG8_STAGE(PG8_SB(0, 1), cB + hstep, voffB); PG8_STAGE(PG8_SA(0, 1), cA + hstep, voffA);
        if (wr == 1) PG8_BAR;
        PG8_WAIT_V(4); PG8_BAR;
        PG8_STAGE(PG8_SB(1, 0), cB + kstep, voffB); PG8_STAGE(PG8_SA(1, 0), cA + kstep, voffA); PG8_STAGE(PG8_SB(1, 1), cB + hstep + kstep, voffB);
        PG8_WAIT_V(6); PG8_BAR;
    }
    for (;;) {
        const bool has_next = S.next(ui + 1, nxt);
        const char* nA = has_next ? (const char*)g.A + (size_t)nxt.pm * tstep : cA; const char* nB = has_next ? (const char*)g.Bt + (size_t)nxt.pn * tstep : cB;
        for (int t = 0; t < nt; t += 2) {
            const bool last = (t == nt - 2);
            const char* a1 = cA + (size_t)(t + 1) * kstep;
            const char* a2 = last ? nA : cA + (size_t)(t + 2) * kstep; const char* b2 = last ? nB : cB + (size_t)(t + 2) * kstep;
            const char* a3 = a2 + kstep; const char* b3 = b2 + kstep;
            if (last && has_next) S.a_ready(nxt);
            if constexpr (SP2) {
            PG8_LDB(B0, 0, 0); PG8_LDB(B1, 0, 1); PG8_SCHED; PG8_LDA(At, 0, 0); PG8_STAGE(PG8_SA(1, 1), a1 + hstep, voffA);
            PG8_WAIT_V(8); PG8_WAIT_L(0); PG8_BAR; PG8_MMA(0, 0, At, B0); PG8_MMA(0, 1, At, B1); PG8_BAR; PG8_SCHED;
            PG8_LDA(At, 0, 1); PG8_STAGE(PG8_SB(0, 0), b2, voffB); PG8_STAGE(PG8_SB(0, 1), b2 + hstep, voffB); PG8_STAGE(PG8_SA(0, 0), a2, voffA);
            PG8_WAIT_V(8); PG8_WAIT_L(0); PG8_BAR; PG8_MMA(1, 0, At, B0); PG8_MMA(1, 1, At, B1); PG8_BAR; PG8_SCHED;
            PG8_LDB(B0, 1, 0); PG8_LDB(B1, 1, 1); PG8_SCHED; PG8_LDA(At, 1, 0); PG8_STAGE(PG8_SA(0, 1), a2 + hstep, voffA);
            PG8_WAIT_V(8); PG8_WAIT_L(0); PG8_BAR; PG8_MMA(0, 0, At, B0); PG8_MMA(0, 1, At, B1); PG8_BAR; PG8_SCHED;
            PG8_LDA(At, 1, 1); PG8_STAGE(PG8_SB(1, 0), b3, voffB); PG8_STAGE(PG8_SB(1, 1), b3 + hstep, voffB); PG8_STAGE(PG8_SA(1, 0), a3, voffA);
            PG8_WAIT_V(8); PG8_WAIT_L(0); PG8_BAR; PG8_MMA(1, 0, At, B0); PG8_MMA(1, 1, At, B1); PG8_BAR; PG8_SCHED;
            } else {
            PG8_LDB(B0, 0, 0); PG8_SCHED; PG8_LDA(At, 0, 0); PG8_STAGE(PG8_SA(1, 1), a1 + hstep, voffA);
            PG8_WAIT_L(8); PG8_BAR; PG8_WAIT_L(0); PG8_MMA(0, 0, At, B0); PG8_BAR; PG8_SCHED;
            PG8_LDB(B1, 0, 1); PG8_STAGE(PG8_SB(0, 0), b2, voffB);
            PG8_BAR; PG8_WAIT_L(0); PG8_MMA(0, 1, At, B1); PG8_BAR;
            PG8_LDA(At, 0, 1); PG8_STAGE(PG8_SA(0, 0), a2, voffA);
            PG8_BAR; PG8_WAIT_L(0); PG8_MMA(1, 0, At, B0); PG8_BAR; PG8_SCHED;
            PG8_STAGE(PG8_SB(0, 1), b2 + hstep, voffB);
            PG8_WAIT_V(6); PG8_BAR; PG8_MMA(1, 1, At, B1); PG8_BAR;
            PG8_LDB(B0, 1, 0); PG8_SCHED; PG8_LDA(At, 1, 0); PG8_STAGE(PG8_SA(0, 1), a2 + hstep, voffA);
            PG8_WAIT_L(8); PG8_BAR; PG8_WAIT_L(0); PG8_MMA(0, 0, At, B0); PG8_BAR; PG8_SCHED;
            PG8_LDB(B1, 1, 1); PG8_STAGE(PG8_SB(1, 0), b3, voffB);
            PG8_BAR; PG8_WAIT_L(0); PG8_MMA(0, 1, At, B1); PG8_BAR;
            PG8_LDA(At, 1, 1); PG8_STAGE(PG8_SA(1, 0), a3, voffA);
            PG8_BAR; PG8_WAIT_L(0); PG8_MMA(1, 0, At, B0); PG8_BAR; PG8_SCHED;
            PG8_STAGE(PG8_SB(1, 1), b3 + hstep, voffB);
            PG8_WAIT_V(6); PG8_BAR; PG8_MMA(1, 1, At, B1); PG8_BAR;
            }
        }
        if constexpr (ALIGN_EPI) { if (wr == 0) PG8_BAR; }
        if constexpr (!Epi::AFTER_DRAIN) { E(acc, cur, wr, wc, fr, fq); S.done(cur); }
        if (!has_next) break;
#pragma unroll
        for (int a = 0; a < 2; ++a)
#pragma unroll
            for (int b = 0; b < 2; ++b)
#pragma unroll
                for (int m = 0; m < 4; ++m)
#pragma unroll
                    for (int n = 0; n < 2; ++n) acc[a][b][m][n] = (f32x4){0.f, 0.f, 0.f, 0.f};
        cur = nxt; cA = nA; cB = nB; ++ui;
        if constexpr (ALIGN_EPI) { if (wr == 1) PG8_BAR; }
    }
    PG8_WAIT_V(0);
    if constexpr (!ALIGN_EPI) { if (wr == 0) PG8_BAR; }
    PG8_BAR;
    if constexpr (Epi::AFTER_DRAIN) { E.fused(acc, cur, wr, wc, fr, fq, lds, wid, lane); S.done(cur); }
#undef PG8_SA
#undef PG8_SB
#undef PG8_STAGE
#undef PG8_LDA
#undef PG8_LDB
#undef PG8_MMA
#undef PG8_WAIT_V
#undef PG8_WAIT_L
#undef PG8_BAR
#undef PG8_SCHED
}
}

struct EpiProj {
    static constexpr bool PERM = true, AFTER_DRAIN = false;
    u16* O;
    __device__ __forceinline__ void operator()(const pg8::f32x4 (&acc)[2][2][4][2], const pg8::Unit& u, int wr, int wc, int fr, int fq) const {
        const int c0 = u.pn * 256;
        const int mode = (c0 >= C_GA) ? 3 : (c0 >= C_GR) ? 2 : (c0 >= C_KR && c0 < C_VR) ? 1 : 0;
        const int row0 = u.pm * 256 + wr * 64 + fr, col0 = c0 + wc * 32 + 8 * fq;
#pragma unroll
        for (int ai = 0; ai < 2; ++ai)
#pragma unroll
            for (int m = 0; m < 4; ++m) {
                u16* rowp = O + (size_t)(row0 + ai * 128 + m * 16) * NPROJ + col0;
#pragma unroll
                for (int bj = 0; bj < 2; ++bj) {
                    float v[8];
#pragma unroll
                    for (int j = 0; j < 4; ++j) { v[j] = acc[ai][bj][m][0][j]; v[4 + j] = acc[ai][bj][m][1][j]; }
#pragma unroll
                    for (int j = 0; j < 8; ++j) { if (mode == 1) v[j] *= 0.125f; else if (mode == 2) v[j] = siluf_(v[j]); else if (mode == 3) v[j] = sigmoidf_(v[j]); }
                    uint4 w; w.x = pk2(v[0], v[1]); w.y = pk2(v[2], v[3]); w.z = pk2(v[4], v[5]); w.w = pk2(v[6], v[7]);
                    *(uint4*)(rowp + bj * 128) = w;
                }
                asm volatile("" ::: "memory");
            }
    }
};
template <int STEP  > struct EpiMerge {
    static constexpr bool PERM = true, AFTER_DRAIN = false;
    u16* MG; const u16* PROJ;
    __device__ __forceinline__ void operator()(const pg8::f32x4 (&acc)[2][2][4][2], const pg8::Unit& u, int wr, int wc, int fr, int fq) const {
        const int row0 = u.pm * 256 + wr * 64 + fr, col0 = u.pn * 256 + wc * 32 + 8 * fq;
#pragma unroll
        for (int ai = 0; ai < 2; ++ai)
#pragma unroll
            for (int m = 0; m < 4; ++m) {
                const size_t row = (size_t)(row0 + ai * 128 + m * 16);
#pragma unroll
                for (int bj = 0; bj < 2; ++bj) {
                    const int col = col0 + bj * 128;
                    const uint4 g = *(const uint4*)(PROJ + row * NPROJ + (STEP == 0 ? C_GA : C_GT) + col);
                    const unsigned gw[4] = {g.x, g.y, g.z, g.w};
                    float v[8];
#pragma unroll
                    for (int j = 0; j < 4; ++j) { v[j] = acc[ai][bj][m][0][j]; v[4 + j] = acc[ai][bj][m][1][j]; }
#pragma unroll
                    for (int j = 0; j < 4; ++j) { v[2 * j] *= bf2f((u16)(gw[j] & 0xffff)); v[2 * j + 1] *= bf2f((u16)(gw[j] >> 16)); }
                    if (STEP == 1) {
                        const uint4 t = *(const uint4*)(MG + row * 1024 + col);
                        const unsigned tw[4] = {t.x, t.y, t.z, t.w};
#pragma unroll
                        for (int j = 0; j < 4; ++j) { v[2 * j] += bf2f((u16)(tw[j] & 0xffff)); v[2 * j + 1] += bf2f((u16)(tw[j] >> 16)); }
                    }
                    uint4 w; w.x = pk2(v[0], v[1]); w.y = pk2(v[2], v[3]); w.z = pk2(v[4], v[5]); w.w = pk2(v[6], v[7]);
                    *(uint4*)(MG + row * 1024 + col) = w;
                }
                asm volatile("" ::: "memory");
            }
    }
};
struct EpiOut {
    static constexpr bool PERM = false, AFTER_DRAIN = false;
    const float* x; const float* mod; float* X1;
    __device__ __forceinline__ void operator()(const pg8::f32x4 (&acc)[2][2][4][2], const pg8::Unit& u, int wr, int wc, int fr, int fq) const {
        const int row0 = u.pm * 256 + wr * 64 + fr, col0 = u.pn * 256 + wc * 32 + 4 * fq;
        const float* gt1 = mod + (u.pm * 256 >= SEQ ? 6144 : 0) + 2048;
#pragma unroll
        for (int ai = 0; ai < 2; ++ai)
#pragma unroll
            for (int m = 0; m < 4; ++m) {
                const size_t row = (size_t)(row0 + ai * 128 + m * 16);
#pragma unroll
                for (int bj = 0; bj < 2; ++bj)
#pragma unroll
                    for (int n = 0; n < 2; ++n) {
                        const int col = col0 + bj * 128 + n * 16;
                        const float4 xv = *(const float4*)(x + row * D + col), gv = *(const float4*)(gt1 + col);
                        float4 o; o.x = xv.x + gv.x * acc[ai][bj][m][n][0]; o.y = xv.y + gv.y * acc[ai][bj][m][n][1]; o.z = xv.z + gv.z * acc[ai][bj][m][n][2]; o.w = xv.w + gv.w * acc[ai][bj][m][n][3];
                        *(float4*)(X1 + row * D + col) = o;
                    }
                asm volatile("" ::: "memory");
            }
    }
};
struct EpiLogits {
    static constexpr bool PERM = false, AFTER_DRAIN = false;
    float* LG;
    __device__ __forceinline__ void operator()(const pg8::f32x4 (&acc)[2][2][4][2], const pg8::Unit& u, int wr, int wc, int fr, int fq) const {
        const int row0 = u.pm * 256 + wr * 64 + fr, col0 = wc * 32 + 4 * fq;
#pragma unroll
        for (int ai = 0; ai < 2; ++ai)
#pragma unroll
            for (int m = 0; m < 4; ++m)
#pragma unroll
                for (int bj = 0; bj < 2; ++bj)
#pragma unroll
                    for (int n = 0; n < 2; ++n) *(pg8::f32x4*)(LG + (size_t)(row0 + ai * 128 + m * 16) * 256 + col0 + bj * 128 + n * 16) = acc[ai][bj][m][n];
    }
};

struct EpiRouterShared {
    static constexpr bool PERM = false, AFTER_DRAIN = false;
    float* LG; u16* GSH;
    __device__ __forceinline__ void operator()(const pg8::f32x4 (&acc)[2][2][4][2], const pg8::Unit& u, int wr, int wc, int fr, int fq) const {
        const int row0 = u.pm * 256 + wr * 64 + fr;
        if (u.pn == 0) {
            const int col0 = wc * 32 + 4 * fq;
#pragma unroll
            for (int ai = 0; ai < 2; ++ai)
#pragma unroll
                for (int m = 0; m < 4; ++m)
#pragma unroll
                    for (int bj = 0; bj < 2; ++bj)
#pragma unroll
                        for (int n = 0; n < 2; ++n) *(pg8::f32x4*)(LG + (size_t)(row0 + ai * 128 + m * 16) * 256 + col0 + bj * 128 + n * 16) = acc[ai][bj][m][n];
        } else {
            const int g0 = (u.pn - 1) * 128 + wc * 16 + 4 * fq;
#pragma unroll
            for (int ai = 0; ai < 2; ++ai)
#pragma unroll
                for (int m = 0; m < 4; ++m)
#pragma unroll
                    for (int bj = 0; bj < 2; ++bj) {
                        float g[4];
#pragma unroll
                        for (int j = 0; j < 4; ++j) g[j] = siluf_(acc[ai][bj][m][0][j]) * acc[ai][bj][m][1][j];
                        uint2 w; w.x = pk2(g[0], g[1]); w.y = pk2(g[2], g[3]);
                        *(uint2*)(GSH + (size_t)(row0 + ai * 128 + m * 16) * 256 + g0 + bj * 64) = w;
                    }
        }
    }
};
struct EpiSharedOut {
    static constexpr bool PERM = true, AFTER_DRAIN = false;
    u16* OS;
    __device__ __forceinline__ void operator()(const pg8::f32x4 (&acc)[2][2][4][2], const pg8::Unit& u, int wr, int wc, int fr, int fq) const {
        const int row0 = u.pm * 256 + wr * 64 + fr, col0 = u.pn * 256 + wc * 32 + 8 * fq;
#pragma unroll
        for (int ai = 0; ai < 2; ++ai)
#pragma unroll
            for (int m = 0; m < 4; ++m) {
                u16* rowp = OS + ((size_t)T * 8 + row0 + ai * 128 + m * 16) * 1024 + col0;
#pragma unroll
                for (int bj = 0; bj < 2; ++bj) {
                    uint4 w; w.x = pk2(acc[ai][bj][m][0][0], acc[ai][bj][m][0][1]); w.y = pk2(acc[ai][bj][m][0][2], acc[ai][bj][m][0][3]);
                    w.z = pk2(acc[ai][bj][m][1][0], acc[ai][bj][m][1][1]); w.w = pk2(acc[ai][bj][m][1][2], acc[ai][bj][m][1][3]);
                    *(uint4*)(rowp + bj * 128) = w;
                }
            }
    }
};

template <int MODE  >
__device__ __forceinline__ int dst_row(int n) { return MODE == 0 ? n : ((n >> 4) * 32 + (n & 15) + (MODE == 2 ? 16 : 0)); }

template <int MODE>
__device__ __forceinline__ void transpose_tile(const float* src, int N, int K, u16* dst, int k0, int n0, unsigned char* smem) {
    u16* tl = (u16*)smem;
    const int tid = opaque_tid();
    {
        const int kr = tid >> 4, nc = tid & 15;
#pragma unroll
        for (int pss = 0; pss < 2; ++pss) {
            const int k = kr + 32 * pss;
            const float4 v = *(const float4*)(src + (size_t)(k0 + k) * N + n0 + nc * 4);
            tl[(nc * 4 + 0) * 72 + k] = f2bf(v.x); tl[(nc * 4 + 1) * 72 + k] = f2bf(v.y);
            tl[(nc * 4 + 2) * 72 + k] = f2bf(v.z); tl[(nc * 4 + 3) * 72 + k] = f2bf(v.w);
        }
    }
    __syncthreads();
    {
        const int n = tid >> 3, kc = tid & 7;
        const uint4 v = *(const uint4*)(tl + n * 72 + kc * 8);
        *(uint4*)(dst + (size_t)dst_row<MODE>(n0 + n) * K + k0 + kc * 8) = v;
    }
    __syncthreads();
}

template <int MODE>
__device__ __forceinline__ void transpose_job(const float* src, int K, int N, u16* dst, unsigned char* smem, int bid, int nb) {
    const int tk = K / 64, tn = N / 64;
    for (int t = bid; t < tk * tn; t += nb) transpose_tile<MODE>(src, N, K, dst, (t % tk) * 64, (t / tk) * 64, smem);
}

__device__ __forceinline__ void phase_prologue(const Params& p, unsigned char* smem, int bid, int nb) {
    const int tid = opaque_tid();
    unsigned char* ws = p.ws;
    for (int item = bid; item < 192; item += nb) {
        float* red = (float*)smem;
        const int cg = tid & 7, rg = tid >> 3;
        const int col = item * 32 + cg * 4;
        float a0[4] = {0, 0, 0, 0}, a1[4] = {0, 0, 0, 0};
        for (int i = 0; i < 16; ++i) {
            const int r = rg * 16 + i;
            const float4 w = *(const float4*)(p.w_ada + (size_t)r * 6144 + col);
            const float c0 = p.c[r], c1 = p.c[1024 + r];
            const float s0 = siluf_(c0), s1 = siluf_(c1);
            a0[0] += s0 * w.x; a0[1] += s0 * w.y; a0[2] += s0 * w.z; a0[3] += s0 * w.w;
            a1[0] += s1 * w.x; a1[1] += s1 * w.y; a1[2] += s1 * w.z; a1[3] += s1 * w.w;
        }
#pragma unroll
        for (int j = 0; j < 4; ++j) { red[(rg * 2 + 0) * 32 + cg * 4 + j] = a0[j]; red[(rg * 2 + 1) * 32 + cg * 4 + j] = a1[j]; }
        __syncthreads();
        if (tid < 64) {
            const int b = tid >> 5, cc = tid & 31;
            float s = 0.f;
            for (int r = 0; r < 64; ++r) s += red[(r * 2 + b) * 32 + cc];
            ((float*)(ws + WS_MOD))[b * 6144 + item * 32 + cc] = s + p.b_ada[item * 32 + cc];
        }
        __syncthreads();
    }
    transpose_job<0>(p.w_in, 1024, NPROJ, (u16*)(ws + WS_WTIN), smem, bid, nb);
    transpose_job<0>(p.w_pa, 512, 1024, (u16*)(ws + WS_WTPA), smem, bid, nb);
    transpose_job<0>(p.w_pr, 1024, 1024, (u16*)(ws + WS_WTPR), smem, bid, nb);
    transpose_job<0>(p.w_out, 1024, 1024, (u16*)(ws + WS_WTOUT), smem, bid, nb);
    transpose_job<0>(p.w_router, 1024, 256, (u16*)(ws + WS_WTRT), smem, bid, nb);
    transpose_job<1>(p.ws1, 1024, 256, (u16*)(ws + WS_WTS13), smem, bid, nb);
    transpose_job<2>(p.ws3, 1024, 256, (u16*)(ws + WS_WTS13), smem, bid, nb);
    transpose_job<0>(p.ws2, 256, 1024, (u16*)(ws + WS_WTS2), smem, bid, nb);
}

__device__ __forceinline__ void phase_norm_mod(const float* xin, const float* g, const float* mod, int sh_off, int sc_off, u16* hout, int bid, int nb) {
    const int tid_ = opaque_tid(); const int lane = tid_ & 63, gw = bid * (NT / 64) + (tid_ >> 6), nw = nb * (NT / 64);
    float4 ca[4], cb[4];
    int curb = -1;
    for (int row = gw; row < T; row += nw) {
        const float* xr = xin + (size_t)row * D;
        const int bt = row >= SEQ ? 1 : 0;
        float4 v[4]; float ss = 0.f;
#pragma unroll
        for (int i = 0; i < 4; ++i) { v[i] = *(const float4*)(xr + ((i >> 1) * 64 + lane) * 8 + (i & 1) * 4); ss += v[i].x * v[i].x + v[i].y * v[i].y + v[i].z * v[i].z + v[i].w * v[i].w; }
        if (bt != curb) {
            curb = bt;
            const float* mb = mod + bt * 6144;
#pragma unroll
            for (int i = 0; i < 4; ++i) {
                const int col = ((i >> 1) * 64 + lane) * 8 + (i & 1) * 4;
                const float4 gg = *(const float4*)(g + col), sc = *(const float4*)(mb + sc_off + col);
                cb[i] = *(const float4*)(mb + sh_off + col);
                ca[i].x = gg.x * (1.f + sc.x); ca[i].y = gg.y * (1.f + sc.y); ca[i].z = gg.z * (1.f + sc.z); ca[i].w = gg.w * (1.f + sc.w);
            }
        }
        ss = wave_sum(ss);
        const float rstd = rsqrtf(ss * (1.0f / D) + 1e-6f);
#pragma unroll
        for (int i = 0; i < 2; ++i) {
            const int col = (i * 64 + lane) * 8;
            unsigned w[4];
#pragma unroll
            for (int h = 0; h < 2; ++h) {
                const float4 x = v[i * 2 + h], a4 = ca[i * 2 + h], b4 = cb[i * 2 + h];
                w[h * 2] = pk2(x.x * rstd * a4.x + b4.x, x.y * rstd * a4.y + b4.y); w[h * 2 + 1] = pk2(x.z * rstd * a4.z + b4.z, x.w * rstd * a4.w + b4.w);
            }
            uint4 wv; wv.x = w[0]; wv.y = w[1]; wv.z = w[2]; wv.w = w[3];
            *(uint4*)(hout + (size_t)row * D + col) = wv;
        }
    }
}

__device__ __forceinline__ int vcu_of(int bid, int nb) { return (nb % 8 == 0) ? (bid % 8) * (nb / 8) + bid / 8 : bid; }

__device__ __forceinline__ void phase_proj(const Params& p, unsigned char* smem, int bid, int nb) {
    pg8::Gemm g{(const u16*)(p.ws + WS_H), (const u16*)(p.ws + WS_WTIN), T, NPROJ, D};
    pg8::StaticOrder S; S.init(T, NPROJ, nb, bid);
    EpiProj E{(u16*)(p.ws + WS_PROJ)};
    pg8::gemm_phase<EpiProj, pg8::StaticOrder, true, true>((LAS unsigned char*)smem, g, S, E);
}

__device__ __forceinline__ float log2_gamma(int h) { return log2f(1.0f - exp2f(-5.0f - (float)h)); }

constexpr int KT_PITCH = 136;
constexpr int VT_PITCH = 288;

__device__ __forceinline__ void phase_kmean_kv(const Params& p, unsigned char* smem, int bid, int nb) {
    const int tid = opaque_tid(), lane = tid & 63, wid = tid >> 6, fr = lane & 15, fq = lane >> 4;
    const u16* PROJ = (const u16*)(p.ws + WS_PROJ);
    for (int item = bid; item < 512; item += nb) {
        const int b = item >> 8, h = (item >> 5) & 7, blk = item & 31;
        float* red = (float*)smem;
        const int r = tid >> 3, c = tid & 7;
        float s[8] = {0, 0, 0, 0, 0, 0, 0, 0};
#pragma unroll
        for (int ps = 0; ps < 4; ++ps) {
            const size_t row = (size_t)b * SEQ + blk * 256 + ps * 64 + r;
            const uint4 v = *(const uint4*)(PROJ + row * NPROJ + C_KA + h * 64 + c * 8);
            const unsigned w[4] = {v.x, v.y, v.z, v.w};
#pragma unroll
            for (int j = 0; j < 4; ++j) { s[2 * j] += bf2f((u16)(w[j] & 0xffff)); s[2 * j + 1] += bf2f((u16)(w[j] >> 16)); }
        }
#pragma unroll
        for (int j = 0; j < 8; ++j) red[r * 64 + c * 8 + j] = s[j];
        __syncthreads();
        if (tid < 64) {
            float a = 0.f;
            for (int rr = 0; rr < 64; ++rr) a += red[rr * 64 + tid];
            ((float*)(p.ws + WS_KMEAN))[(size_t)item * 64 + tid] = a * (1.0f / 256.0f);
        }
        __syncthreads();
    }
    {
        unsigned char* Ks = smem;
        unsigned char* Vs = smem + 128 * KT_PITCH;
        uint4 kreg0, kreg1, vreg0, vreg1, vreg2, vreg3;
#define KV_LOAD(item_) do { const int b_ = (item_) >> 9, h_ = ((item_) >> 6) & 7, c_ = (item_) & 63; const size_t row0_ = (size_t)b_ * SEQ + c_ * 128; \
            const u16* kp_ = PROJ + (row0_ + (tid >> 3)) * NPROJ + C_KR + h_ * 64 + (tid & 7) * 8; const u16* vp_ = PROJ + (row0_ + (tid >> 4)) * NPROJ + C_VR + h_ * 128 + (tid & 15) * 8; \
            kreg0 = *(const uint4*)kp_; kreg1 = *(const uint4*)(kp_ + (size_t)64 * NPROJ); \
            vreg0 = *(const uint4*)vp_; vreg1 = *(const uint4*)(vp_ + (size_t)32 * NPROJ); vreg2 = *(const uint4*)(vp_ + (size_t)64 * NPROJ); vreg3 = *(const uint4*)(vp_ + (size_t)96 * NPROJ); } while (0)
        int item = bid;
        KV_LOAD(item < 1024 ? item : 0);
        for (; item < 1024; item += nb) {
            const int h = (item >> 6) & 7;
            const float l2g = log2_gamma(h);
            {
#pragma unroll
                for (int i = 0; i < 2; ++i) {
                    const int r = (tid >> 3) + 64 * i, pc = tid & 7;
                    const uint4 v = i ? kreg1 : kreg0;
                    const float dec = exp2f((float)(127 - r) * l2g);
                    const unsigned w[4] = {v.x, v.y, v.z, v.w}; unsigned o[4];
#pragma unroll
                    for (int j = 0; j < 4; ++j) o[j] = pk2(bf2f((u16)(w[j] & 0xffff)) * dec, bf2f((u16)(w[j] >> 16)) * dec);
                    *(uint2*)(Ks + r * KT_PITCH + pc * 16) = make_uint2(o[0], o[1]);
                    *(uint2*)(Ks + r * KT_PITCH + pc * 16 + 8) = make_uint2(o[2], o[3]);
                }
#pragma unroll
                for (int i = 0; i < 4; ++i) {
                    const int r = (tid >> 4) + 32 * i, pc = tid & 15;
                    *(uint4*)(Vs + r * VT_PITCH + pc * 16) = (i == 0) ? vreg0 : (i == 1) ? vreg1 : (i == 2) ? vreg2 : vreg3;
                }
            }
            __syncthreads();
            { const int nx_ = (item + nb < 1024) ? item + nb : item; KV_LOAD(nx_); }
            f32x4 acc[4];
#pragma unroll
            for (int dt = 0; dt < 4; ++dt) acc[dt] = (f32x4){0.f, 0.f, 0.f, 0.f};
            const unsigned char* vb = tr_lane_base(Vs, VT_PITCH, 8 * fq, lane) + wid * 32;
            const unsigned char* kb = tr_lane_base(Ks, KT_PITCH, 8 * fq, lane);
#pragma unroll
            for (int s = 0; s < 4; ++s) {
                const bf16x8 vf = tr_frag2(vb, (32 * s) * VT_PITCH, (32 * s + 4) * VT_PITCH);
#pragma unroll
                for (int dt = 0; dt < 4; ++dt) {
                    const bf16x8 kf = tr_frag2(kb, (32 * s) * KT_PITCH + dt * 32, (32 * s + 4) * KT_PITCH + dt * 32);
                    acc[dt] = __builtin_amdgcn_mfma_f32_16x16x32_bf16(kf, vf, acc[dt], 0, 0, 0);
                }
            }
            float* KV = (float*)(p.ws + WS_KV) + (size_t)item * 8192;
#pragma unroll
            for (int dt = 0; dt < 4; ++dt) *(f32x4*)(KV + (wid * 16 + fr) * 64 + dt * 16 + 4 * fq) = acc[dt];
            __syncthreads();
        }
#undef KV_LOAD
    }
}

__device__ __forceinline__ int alist_off(int n) { return 256 * (31 * n - (n * (n - 1)) / 2); }

__device__ __forceinline__ void phase_gate_scan(const Params& p, unsigned char* smem, int bid, int nb) {
    const int tid = opaque_tid();
    const u16* PROJ = (const u16*)(p.ws + WS_PROJ);
    unsigned* acnt = (unsigned*)(p.ws + WS_CTL);
    unsigned* alist = (unsigned*)(p.ws + WS_ALIST);
    for (int item = bid; item < 256; item += nb) {
        const int b = item >> 7, h = (item >> 4) & 7, qc = item & 15;
        float* km = (float*)smem;
        unsigned* lcnt = (unsigned*)(smem + 8192);
        unsigned* lbase = lcnt + 32;
        for (int i = tid; i < 2048; i += NT) km[i] = ((const float*)(p.ws + WS_KMEAN))[(size_t)((b * 8 + h) * 32) * 64 + i];
        if (tid < 32) lcnt[tid] = 0;
        __syncthreads();
        const int t = qc * 512 + tid, tb = t >> 8;
        float q[64];
        {
            const u16* qp = PROJ + ((size_t)b * SEQ + t) * NPROJ + C_QA + h * 64;
#pragma unroll
            for (int i = 0; i < 8; ++i) {
                const uint4 v = *(const uint4*)(qp + i * 8);
                const unsigned w[4] = {v.x, v.y, v.z, v.w};
#pragma unroll
                for (int j = 0; j < 4; ++j) { q[i * 8 + 2 * j] = bf2f((u16)(w[j] & 0xffff)); q[i * 8 + 2 * j + 1] = bf2f((u16)(w[j] >> 16)); }
            }
        }
        float v0 = -3e38f, v1 = -3e38f, v2 = -3e38f; int i0 = 0, i1 = 0, i2 = 0;
        for (int n = 0; n < tb; ++n) {
            float g = 0.f;
#pragma unroll
            for (int d = 0; d < 64; ++d) g += q[d] * km[n * 64 + d];
            if (g > v0) { v2 = v1; i2 = i1; v1 = v0; i1 = i0; v0 = g; i0 = n; }
            else if (g > v1) { v2 = v1; i2 = i1; v1 = g; i1 = n; }
            else if (g > v2) { v2 = g; i2 = n; }
        }
        const int nsel = tb < 3 ? tb : 3;
        unsigned lp0 = 0, lp1 = 0, lp2 = 0;
        if (nsel > 0) lp0 = atomicAdd(&lcnt[i0], 1u);
        if (nsel > 1) lp1 = atomicAdd(&lcnt[i1], 1u);
        if (nsel > 2) lp2 = atomicAdd(&lcnt[i2], 1u);
        __syncthreads();
        if (tid < 32) lbase[tid] = lcnt[tid] ? atomicAdd(&acnt[(b * 8 + h) * 32 + tid], lcnt[tid]) : 0u;
        __syncthreads();
        unsigned* lst = alist + (size_t)(b * 8 + h) * ALIST_PER_BH;
        if (nsel > 0) lst[alist_off(i0) + lbase[i0] + lp0] = (unsigned)t | (0u << 16);
        if (nsel > 1) lst[alist_off(i1) + lbase[i1] + lp1] = (unsigned)t | (1u << 16);
        if (nsel > 2) lst[alist_off(i2) + lbase[i2] + lp2] = (unsigned)t | (2u << 16);
        __syncthreads();
    }
    for (int idx = bid * NT + tid; idx < 16 * 8192; idx += nb * NT) {
        const int bh = idx >> 13, el = idx & 8191, h = bh & 7;
        const float cd = exp2f(128.0f * log2_gamma(h));
        const float* KV = (const float*)(p.ws + WS_KV) + (size_t)bh * 64 * 8192 + el;
        u16* SP = (u16*)(p.ws + WS_SPREV) + (size_t)bh * 64 * 8192 + el;
        float s = 0.f;
#pragma unroll 8
        for (int c = 0; c < 64; ++c) { SP[(size_t)c * 8192] = f2bf(s); s = cd * s + KV[(size_t)c * 8192]; }
    }
}

__device__ __forceinline__ void attn_wave(const Params& p, const unsigned char* Ks, const unsigned char* Vs, int b, int h, int tq  , bool valid, int kblk, int slot,
                                          int ntmax, bool causal, int lane) {
    const int fr = lane & 15, fq = lane >> 4;
    const u16* PROJ = (const u16*)(p.ws + WS_PROJ);
    const size_t qrow = (size_t)b * SEQ + tq;
    bf16x8 qf[2];
#pragma unroll
    for (int ks = 0; ks < 2; ++ks) qf[ks] = *(const bf16x8*)(PROJ + qrow * NPROJ + C_QA + h * 64 + ks * 32 + fq * 8);
    f32x4 s[16];
    const unsigned char* kb[2] = {Ks + swz_off(fr, fq), Ks + swz_off(fr, 4 + fq)};
#pragma unroll
    for (int nt = 0; nt < 16; ++nt) {
        s[nt] = (f32x4){0.f, 0.f, 0.f, 0.f};
        if (nt <= ntmax) {
#pragma unroll
            for (int ks = 0; ks < 2; ++ks) {
                const bf16x8 kf = *(const bf16x8*)(kb[ks] + nt * 2048);
                s[nt] = __builtin_amdgcn_mfma_f32_16x16x32_bf16(kf, qf[ks], s[nt], 0, 0, 0);
            }
        }
        if ((nt & 3) == 3) __builtin_amdgcn_sched_barrier(0);
    }
    const float slope = exp2f(-(float)(h + 1));
    const int ql = tq - kblk * 256;
    float m = -1e30f;
#pragma unroll
    for (int nt = 0; nt < 16; ++nt) {
#pragma unroll
        for (int j = 0; j < 4; ++j) {
            const int key = nt * 16 + 4 * fq + j;
            float v = s[nt][j] * 0.125f - slope * (float)(ql - key);
            if (nt > ntmax || (causal && key > ql)) v = -1e30f;
            s[nt][j] = v; m = fmaxf(m, v);
        }
    }
    m = fmaxf(m, __shfl_xor(m, 16)); m = fmaxf(m, __shfl_xor(m, 32));
    float l = 0.f;
#pragma unroll
    for (int nt = 0; nt < 16; ++nt)
#pragma unroll
        for (int j = 0; j < 4; ++j) { const float e = (s[nt][j] > -1e29f) ? __expf(s[nt][j] - m) : 0.f; s[nt][j] = e; l += e; }
    l += __shfl_xor(l, 16); l += __shfl_xor(l, 32);
    f32x4 o[4];
#pragma unroll
    for (int dt = 0; dt < 4; ++dt) o[dt] = (f32x4){0.f, 0.f, 0.f, 0.f};
    const unsigned char* vb = tr_lane_base(Vs, KT_PITCH, 4 * fq, lane);
#pragma unroll
    for (int st = 0; st < 8; ++st) {
        if (2 * st <= ntmax) {
            bf16x8 pf;
            {
                const unsigned a0 = pk2(s[2 * st][0], s[2 * st][1]), a1 = pk2(s[2 * st][2], s[2 * st][3]);
                const unsigned b0 = pk2(s[2 * st + 1][0], s[2 * st + 1][1]), b1 = pk2(s[2 * st + 1][2], s[2 * st + 1][3]);
                pf = (bf16x8){(short)(a0 & 0xffff), (short)(a0 >> 16), (short)(a1 & 0xffff), (short)(a1 >> 16), (short)(b0 & 0xffff), (short)(b0 >> 16), (short)(b1 & 0xffff), (short)(b1 >> 16)};
            }
#pragma unroll
            for (int dt = 0; dt < 4; ++dt) {
                const bf16x8 vf = tr_frag2(vb, (32 * st) * KT_PITCH + dt * 32, (32 * st + 16) * KT_PITCH + dt * 32);
                o[dt] = __builtin_amdgcn_mfma_f32_16x16x32_bf16(vf, pf, o[dt], 0, 0, 0);
            }
        }
        if (st & 1) __builtin_amdgcn_sched_barrier(0);
    }
    if (valid) {
        const float inv = 1.0f / l;
        const size_t pidx = ((qrow * 8 + h) * 4 + slot);
        u16* OP = (u16*)(p.ws + WS_OPART) + pidx * 64;
#pragma unroll
        for (int dt = 0; dt < 4; ++dt) {
            uint2 w; w.x = pk2(o[dt][0] * inv, o[dt][1] * inv); w.y = pk2(o[dt][2] * inv, o[dt][3] * inv);
            *(uint2*)(OP + dt * 16 + 4 * fq) = w;
        }
        if (fq == 0) { float2 ml; ml.x = m; ml.y = l; *(float2*)((float*)(p.ws + WS_ML) + pidx * 2) = ml; }
    }
}


template <bool CAUSAL>
__device__ __forceinline__ void attn_wave2(const Params& p, unsigned lds_k, unsigned lds_v, const bf16x8 (&qf)[2], int b, int h, int tq, bool valid, int kblk, int slot,
                                           int ntmax_rt, int lane) {
    const int ntmax = CAUSAL ? ntmax_rt : 15; constexpr bool causal = CAUSAL;
    const int fr = lane & 15, fq = lane >> 4;
    const size_t qrow = (size_t)b * SEQ + tq;
    f32x4 s[16];
    const LAS unsigned char* kb0 = (const LAS unsigned char*)(size_t)(lds_k + swz_off(fr, fq));
    const LAS unsigned char* kb1 = (const LAS unsigned char*)(size_t)(lds_k + swz_off(fr, 4 + fq));
#pragma unroll
    for (int nt = 0; nt < 16; ++nt) {
        s[nt] = (f32x4){0.f, 0.f, 0.f, 0.f};
        if (nt <= ntmax) {
            const bf16x8 k0 = *(const LAS bf16x8*)(kb0 + nt * 2048), k1 = *(const LAS bf16x8*)(kb1 + nt * 2048);
            s[nt] = __builtin_amdgcn_mfma_f32_16x16x32_bf16(k0, qf[0], s[nt], 0, 0, 0);
            s[nt] = __builtin_amdgcn_mfma_f32_16x16x32_bf16(k1, qf[1], s[nt], 0, 0, 0);
        }
        if ((nt & 3) == 3) __builtin_amdgcn_sched_barrier(0);
    }
    const float slope2 = exp2f(-(float)(h + 1)) * 1.44269504f, c1 = 0.125f * 1.44269504f;
    const int ql = tq - kblk * 256;
    const float kbase = slope2 * (float)(4 * fq - ql);
    float m = -1e30f;
    if (!causal) {
        float mp[4] = {-1e30f, -1e30f, -1e30f, -1e30f};
#pragma unroll
        for (int nt = 0; nt < 16; ++nt) {
#pragma unroll
            for (int j = 0; j < 4; ++j) { const float v = fmaf(s[nt][j], c1, kbase + slope2 * (float)(16 * nt + j)); s[nt][j] = v; mp[j] = fmaxf(mp[j], v); }
        }
        m = fmaxf(fmaxf(mp[0], mp[1]), fmaxf(mp[2], mp[3]));
    } else {
#pragma unroll
        for (int nt = 0; nt < 16; ++nt) {
#pragma unroll
            for (int j = 0; j < 4; ++j) {
                const int key = nt * 16 + 4 * fq + j;
                float v = fmaf(s[nt][j], c1, kbase + slope2 * (float)(16 * nt + j));
                if (nt > ntmax || key > ql) v = -1e30f;
                s[nt][j] = v; m = fmaxf(m, v);
            }
        }
    }
    m = fmaxf(m, __shfl_xor(m, 16)); m = fmaxf(m, __shfl_xor(m, 32));
    float lp[4] = {0.f, 0.f, 0.f, 0.f};
#pragma unroll
    for (int nt = 0; nt < 16; ++nt)
#pragma unroll
        for (int j = 0; j < 4; ++j) { const float e = __builtin_amdgcn_exp2f(s[nt][j] - m); s[nt][j] = e; lp[j] += e; }
    float l = (lp[0] + lp[1]) + (lp[2] + lp[3]);
    l += __shfl_xor(l, 16); l += __shfl_xor(l, 32);
    m *= 0.69314718f;
    f32x4 o[4];
#pragma unroll
    for (int dt = 0; dt < 4; ++dt) o[dt] = (f32x4){0.f, 0.f, 0.f, 0.f};
    const int i16 = lane & 15, q4 = i16 >> 2, p4 = i16 & 3, vmask = ((2 * fq + (q4 >> 1)) & 3) << 1;
    unsigned va[4];
#pragma unroll
    for (int dt = 0; dt < 4; ++dt) va[dt] = lds_v + (unsigned)((4 * fq + q4) * 128 + ((((dt * 2 + (p4 >> 1)) ^ vmask)) << 4) + (p4 & 1) * 8);
#pragma unroll
    for (int st = 0; st < 8; ++st) {
        if (2 * st <= ntmax) {
            bf16x8 pf;
            {
                const unsigned a0 = pk2(s[2 * st][0], s[2 * st][1]), a1 = pk2(s[2 * st][2], s[2 * st][3]);
                const unsigned b0 = pk2(s[2 * st + 1][0], s[2 * st + 1][1]), b1 = pk2(s[2 * st + 1][2], s[2 * st + 1][3]);
                pf = (bf16x8){(short)(a0 & 0xffff), (short)(a0 >> 16), (short)(a1 & 0xffff), (short)(a1 >> 16), (short)(b0 & 0xffff), (short)(b0 >> 16), (short)(b1 & 0xffff), (short)(b1 >> 16)};
            }
            bf16x4 tl[4], th[4];
            TR_READ_ASM(tl[0], va[0], st * 4096); TR_READ_ASM(th[0], va[0], st * 4096 + 2048);
            TR_READ_ASM(tl[1], va[1], st * 4096); TR_READ_ASM(th[1], va[1], st * 4096 + 2048);
            TR_READ_ASM(tl[2], va[2], st * 4096); TR_READ_ASM(th[2], va[2], st * 4096 + 2048);
            TR_READ_ASM(tl[3], va[3], st * 4096); TR_READ_ASM(th[3], va[3], st * 4096 + 2048);
            asm volatile("s_waitcnt lgkmcnt(0)" : "+v"(tl[0]), "+v"(tl[1]), "+v"(tl[2]), "+v"(tl[3]), "+v"(th[0]), "+v"(th[1]), "+v"(th[2]), "+v"(th[3]) :: "memory");
            __builtin_amdgcn_sched_barrier(0);
#pragma unroll
            for (int dt = 0; dt < 4; ++dt) {
                const bf16x8 vf = (bf16x8){tl[dt][0], tl[dt][1], tl[dt][2], tl[dt][3], th[dt][0], th[dt][1], th[dt][2], th[dt][3]};
                o[dt] = __builtin_amdgcn_mfma_f32_16x16x32_bf16(vf, pf, o[dt], 0, 0, 0);
            }
        }
    }
    if (valid) {
        const float inv = 1.0f / l;
        const size_t pidx = ((qrow * 8 + h) * 4 + slot);
        u16* OP = (u16*)(p.ws + WS_OPART) + pidx * 64;
#pragma unroll
        for (int dt = 0; dt < 4; ++dt) {
            uint2 w; w.x = pk2(o[dt][0] * inv, o[dt][1] * inv); w.y = pk2(o[dt][2] * inv, o[dt][3] * inv);
            *(uint2*)(OP + dt * 16 + 4 * fq) = w;
        }
        if (fq == 0) { float2 ml; ml.x = m; ml.y = l; *(float2*)((float*)(p.ws + WS_ML) + pidx * 2) = ml; }
    }
}

__device__ __forceinline__ void load_kv_block(const Params& p, unsigned char* Ks, unsigned char* Vs, int b, int h, int kblk) {
    const u16* PROJ = (const u16*)(p.ws + WS_PROJ);
    const int tid = opaque_tid();
#pragma unroll
    for (int i = 0; i < 4; ++i) {
        const int r = (tid >> 3) + 64 * i, pc = tid & 7;
        const size_t row = (size_t)b * SEQ + kblk * 256 + r;
        const uint4 kv = *(const uint4*)(PROJ + row * NPROJ + C_KA + h * 64 + pc * 8);
        const uint4 vv = *(const uint4*)(PROJ + row * NPROJ + C_VA + h * 64 + pc * 8);
        *(uint4*)(Ks + swz_off(r, pc)) = kv;
        *(uint2*)(Vs + r * KT_PITCH + pc * 16) = make_uint2(vv.x, vv.y);
        *(uint2*)(Vs + r * KT_PITCH + pc * 16 + 8) = make_uint2(vv.z, vv.w);
    }
}

__device__ __forceinline__ void phase_attn_ret(const Params& p, unsigned char* smem, int bid, int nb) {
    const int tid = opaque_tid(), lane = tid & 63, wid = tid >> 6, fr = lane & 15, fq = lane >> 4;
    const u16* PROJ = (const u16*)(p.ws + WS_PROJ);
    const unsigned* acnt = (const unsigned*)(p.ws + WS_CTL);
    const unsigned* alist = (const unsigned*)(p.ws + WS_ALIST);
    int* pref = (int*)(smem + 72 * 1024);
    {
        const int c = (int)acnt[tid];
        pref[tid + 1] = (c + 127) >> 7;
        if (tid == 0) pref[0] = 0;
        __syncthreads();
        for (int off = 1; off < 512; off <<= 1) {
            const int v = pref[tid + 1] + ((tid >= off) ? pref[tid + 1 - off] : 0);
            __syncthreads();
            pref[tid + 1] = v;
            __syncthreads();
        }
    }
    const int n_sel = __builtin_amdgcn_readfirstlane(pref[512]);
    const int n_own = 1024, n_ret = 1024;
    const int total = n_sel + n_own + n_ret;
    (void)total;
    {
        const int n_att = n_sel + n_own;
        const unsigned lds0 = (unsigned)(unsigned long long)(LAS unsigned char*)smem;
        const int wu = __builtin_amdgcn_readfirstlane(wid);
        int* pref2 = (int*)(smem + 135168);
        __syncthreads();
        int* cnt2 = pref2 + 516;
        for (int i = tid; i < 513; i += NT) pref2[i] = pref[i];
        cnt2[tid] = (int)acnt[tid];
        __syncthreads();
#define AT_DECODE(item_, B, H, KB, NTM, CAUS, VALID, ENT) do { \
            if ((item_) < n_sel) { int lo_ = 0, hi_ = 512; while (hi_ - lo_ > 1) { const int mid_ = (lo_ + hi_) >> 1; if (pref2[mid_] <= (item_)) lo_ = mid_; else hi_ = mid_; } \
                const int bk_ = __builtin_amdgcn_readfirstlane(lo_), tile_ = (item_) - __builtin_amdgcn_readfirstlane(pref2[bk_]); \
                B = bk_ >> 8; H = (bk_ >> 5) & 7; KB = bk_ & 31; NTM = 15; CAUS = false; \
                const int cnt_ = __builtin_amdgcn_readfirstlane(cnt2[bk_]); const int qi_ = tile_ * 128 + wid * 16 + fr; VALID = qi_ < cnt_; \
                ENT = alist[(size_t)(B * 8 + H) * ALIST_PER_BH + alist_off(KB) + (VALID ? qi_ : 0)]; } \
            else { const int it_ = (item_) - n_sel; const int bk_ = it_ >> 1, half_ = it_ & 1; B = bk_ >> 8; H = (bk_ >> 5) & 7; KB = bk_ & 31; \
                ENT = (unsigned)(KB * 256 + half_ * 128 + wid * 16 + fr) | (3u << 16); NTM = half_ * 8 + wu; CAUS = true; VALID = true; } } while (0)
#define AT_ISSUE_KV(B, H, KB, st_) do { const int lsub_ = lane >> 3, lpp_ = lane & 7; \
            _Pragma("unroll") for (int i_ = 0; i_ < 4; ++i_) { const int r_ = (i_ * 8 + wu) * 8 + lsub_; \
                const u16* rp_ = PROJ + ((size_t)(B) * SEQ + (KB) * 256 + r_) * NPROJ + (H) * 64; \
                __builtin_amdgcn_global_load_lds((const unsigned*)(rp_ + C_KA + ((lpp_ ^ (r_ & 7)) * 8)), (LAS unsigned*)(smem + (st_) * 65536 + (i_ * 8 + wu) * 1024), 16, 0, 0); \
                __builtin_amdgcn_global_load_lds((const unsigned*)(rp_ + C_VA + ((lpp_ ^ (((r_ >> 1) & 3) << 1)) * 8)), (LAS unsigned*)(smem + (st_) * 65536 + 32768 + (i_ * 8 + wu) * 1024), 16, 0, 0); } } while (0)
        int item = bid, st = 0;
        int cb = 0, ch = 0, ckb = 0, cntm = 15; bool ccaus = false, cvalid = false; unsigned cent = 0u;
        int db = 0, dh = 0, dkb = 0, dntm = 15; bool dcaus = false, dvalid = false; unsigned dent = 0u;
        bf16x8 qf[2] = {};
        if (item < n_att) {
            AT_DECODE(item, cb, ch, ckb, cntm, ccaus, cvalid, cent);
            AT_ISSUE_KV(cb, ch, ckb, 0);
#pragma unroll
            for (int ks = 0; ks < 2; ++ks) qf[ks] = *(const bf16x8*)(PROJ + ((size_t)cb * SEQ + (int)(cent & 0xffffu)) * NPROJ + C_QA + ch * 64 + ks * 32 + fq * 8);
            if (item + nb < n_att) AT_DECODE(item + nb, db, dh, dkb, dntm, dcaus, dvalid, dent);
        }
        while (item < n_att) {
            asm volatile("s_waitcnt vmcnt(0)" : "+v"(qf[0]), "+v"(qf[1]), "+v"(dent) :: "memory");
            __syncthreads();
            const int item1 = item + nb, item2 = item + 2 * nb;
            bf16x8 qn[2] = {qf[0], qf[1]};
            if (item1 < n_att) {
                AT_ISSUE_KV(db, dh, dkb, st ^ 1);
#pragma unroll
                for (int ks = 0; ks < 2; ++ks) qn[ks] = *(const bf16x8*)(PROJ + ((size_t)db * SEQ + (int)(dent & 0xffffu)) * NPROJ + C_QA + dh * 64 + ks * 32 + fq * 8);
            }
            int eb = 0, eh = 0, ekb = 0, entm = 15; bool ecaus = false, evalid = false; unsigned eent = 0u;
            if (item2 < n_att) AT_DECODE(item2, eb, eh, ekb, entm, ecaus, evalid, eent);
            if (ccaus) attn_wave2<true>(p, lds0 + st * 65536, lds0 + st * 65536 + 32768, qf, cb, ch, (int)(cent & 0xffffu), cvalid, ckb, (int)(cent >> 16), cntm, lane);
            else attn_wave2<false>(p, lds0 + st * 65536, lds0 + st * 65536 + 32768, qf, cb, ch, (int)(cent & 0xffffu), cvalid, ckb, (int)(cent >> 16), cntm, lane);
            cb = db; ch = dh; ckb = dkb; cntm = dntm; ccaus = dcaus; cvalid = dvalid; cent = dent; qf[0] = qn[0]; qf[1] = qn[1];
            db = eb; dh = eh; dkb = ekb; dntm = entm; dcaus = ecaus; dvalid = evalid; dent = eent;
            st ^= 1; item = item1;
        }
        asm volatile("s_waitcnt vmcnt(0)" ::: "memory");
        __syncthreads();
#undef AT_DECODE
#undef AT_ISSUE_KV
    }
    for (int it = (bid + nb - ((n_sel + n_own) % nb)) % nb; it < n_ret; it += nb) {
        {
            const int b = it >> 9, h = (it >> 6) & 7, c = it & 63;
            unsigned char* Ks = smem;
            unsigned char* Ss = smem + 16384;
            unsigned char* Vs = smem + 32768;
            const size_t row0 = (size_t)b * SEQ + c * 128;
            const u16* SP = (const u16*)(p.ws + WS_SPREV) + (size_t)it * 8192;
            const int m = wid * 16 + fr;
            bf16x8 qf[2];
#pragma unroll
            for (int ks = 0; ks < 2; ++ks) qf[ks] = *(const bf16x8*)(PROJ + (row0 + m) * NPROJ + C_QR + h * 64 + ks * 32 + fq * 8);
            const u16* GR = PROJ + (row0 + m) * NPROJ + C_GR + h * 128;
            uint2 gq[8];
#pragma unroll
            for (int et = 0; et < 8; ++et) gq[et] = *(const uint2*)(GR + et * 16 + 4 * fq);
#pragma unroll
            for (int i = 0; i < 2; ++i) {
                const int r = (tid >> 3) + 64 * i, pc = tid & 7;
                *(uint4*)(Ks + swz_off(r, pc)) = *(const uint4*)(PROJ + (row0 + r) * NPROJ + C_KR + h * 64 + pc * 8);
                *(uint4*)(Ss + swz_off(r, pc)) = *(const uint4*)(SP + r * 64 + pc * 8);
            }
#pragma unroll
            for (int i = 0; i < 4; ++i) {
                const int r = (tid >> 4) + 32 * i, pc = tid & 15;
                *(uint4*)(Vs + r * VT_PITCH + pc * 16) = *(const uint4*)(PROJ + (row0 + r) * NPROJ + C_VR + h * 128 + pc * 8);
            }
            __syncthreads();
            const float l2g = log2_gamma(h);
            f32x4 o[8];
#pragma unroll
            for (int et = 0; et < 8; ++et) {
                o[et] = (f32x4){0.f, 0.f, 0.f, 0.f};
#pragma unroll
                for (int ks = 0; ks < 2; ++ks) {
                    const bf16x8 sf = *(const bf16x8*)(Ss + swz_off(fr, ks * 4 + fq) + et * 2048);
                    o[et] = __builtin_amdgcn_mfma_f32_16x16x32_bf16(sf, qf[ks], o[et], 0, 0, 0);
                }
            }
            const float qdec = exp2f((float)(m + 1) * l2g);
#pragma unroll
            for (int et = 0; et < 8; ++et) o[et] = o[et] * qdec;
            f32x4 s[8];
#pragma unroll
            for (int nt = 0; nt < 8; ++nt) {
                s[nt] = (f32x4){0.f, 0.f, 0.f, 0.f};
                if (nt <= wid) {
#pragma unroll
                    for (int ks = 0; ks < 2; ++ks) {
                        const bf16x8 kf = *(const bf16x8*)(Ks + swz_off(fr, ks * 4 + fq) + nt * 2048);
                        s[nt] = __builtin_amdgcn_mfma_f32_16x16x32_bf16(kf, qf[ks], s[nt], 0, 0, 0);
                    }
#pragma unroll
                    for (int j = 0; j < 4; ++j) {
                        const int n = nt * 16 + 4 * fq + j;
                        s[nt][j] = (n <= m) ? s[nt][j] * exp2f((float)(m - n) * l2g) : 0.f;
                    }
                }
            }
            const unsigned char* vb = tr_lane_base(Vs, VT_PITCH, 4 * fq, lane);
#pragma unroll
            for (int st = 0; st < 4; ++st) {
                if (2 * st <= wid) {
                    bf16x8 pf;
                    {
                        const unsigned a0 = pk2(s[2 * st][0], s[2 * st][1]), a1 = pk2(s[2 * st][2], s[2 * st][3]);
                        const unsigned b0 = pk2(s[2 * st + 1][0], s[2 * st + 1][1]), b1 = pk2(s[2 * st + 1][2], s[2 * st + 1][3]);
                        pf = (bf16x8){(short)(a0 & 0xffff), (short)(a0 >> 16), (short)(a1 & 0xffff), (short)(a1 >> 16), (short)(b0 & 0xffff), (short)(b0 >> 16), (short)(b1 & 0xffff), (short)(b1 >> 16)};
                    }
#pragma unroll
                    for (int et = 0; et < 8; ++et) {
                        const bf16x8 vf = tr_frag2(vb, (32 * st) * VT_PITCH + et * 32, (32 * st + 16) * VT_PITCH + et * 32);
                        o[et] = __builtin_amdgcn_mfma_f32_16x16x32_bf16(vf, pf, o[et], 0, 0, 0);
                    }
                }
            }
            float sum = 0.f;
#pragma unroll
            for (int et = 0; et < 8; ++et) sum += (o[et][0] + o[et][1]) + (o[et][2] + o[et][3]);
            sum += __shfl_xor(sum, 16); sum += __shfl_xor(sum, 32);
            const float mu = sum * (1.0f / 128.0f);
            float var = 0.f;
#pragma unroll
            for (int et = 0; et < 8; ++et)
#pragma unroll
                for (int j = 0; j < 4; ++j) { const float dlt = o[et][j] - mu; var += dlt * dlt; }
            var += __shfl_xor(var, 16); var += __shfl_xor(var, 32);
            const float rstd = rsqrtf(var * (1.0f / 128.0f) + 1e-6f);
            u16* YR = (u16*)(p.ws + WS_YR) + (row0 + m) * 1024 + h * 128;
#pragma unroll
            for (int et = 0; et < 8; ++et) {
                const uint2 g = gq[et];
                const float g0 = bf2f((u16)(g.x & 0xffff)), g1 = bf2f((u16)(g.x >> 16)), g2 = bf2f((u16)(g.y & 0xffff)), g3 = bf2f((u16)(g.y >> 16));
                uint2 w; w.x = pk2((o[et][0] - mu) * rstd * g0, (o[et][1] - mu) * rstd * g1); w.y = pk2((o[et][2] - mu) * rstd * g2, (o[et][3] - mu) * rstd * g3);
                *(uint2*)(YR + et * 16 + 4 * fq) = w;
            }
            __syncthreads();
        }
    }
}

__device__ __forceinline__ void phase_combine(const Params& p, int bid, int nb) {
    const u16* OP = (const u16*)(p.ws + WS_OPART); const float* ML = (const float*)(p.ws + WS_ML); u16* YA = (u16*)(p.ws + WS_YA);
    for (size_t idx = (size_t)bid * NT + opaque_tid(); idx < (size_t)T * 64; idx += (size_t)nb * NT) {
        const size_t th = idx >> 3; const int pc = (int)(idx & 7);
        const int t = (int)((th >> 3) & (SEQ - 1)), tb = t >> 8, nsel = tb < 3 ? tb : 3;
        const float* ml = ML + th * 8;
        const float4 mlA = *(const float4*)ml, mlB = *(const float4*)(ml + 4);
        const float mlv[8] = {mlA.x, mlA.y, mlA.z, mlA.w, mlB.x, mlB.y, mlB.z, mlB.w};
        float mm[4], ll[4]; float M = -1e30f;
#pragma unroll
        for (int s = 0; s < 4; ++s) { const bool on = (s == 3) || (s < nsel); mm[s] = on ? mlv[s * 2] : -1e30f; ll[s] = on ? mlv[s * 2 + 1] : 0.f; M = fmaxf(M, mm[s]); }
        float acc[8] = {0, 0, 0, 0, 0, 0, 0, 0}; float wsum = 0.f;
#pragma unroll
        for (int s = 0; s < 4; ++s) {
            const bool on = (s == 3) || (s < nsel);
            if (on) {
                const float w = ll[s] * __expf(mm[s] - M); wsum += w;
                const uint4 v = *(const uint4*)(OP + (th * 4 + s) * 64 + pc * 8);
                const unsigned ww[4] = {v.x, v.y, v.z, v.w};
#pragma unroll
                for (int j = 0; j < 4; ++j) { acc[2 * j] += w * bf2f((u16)(ww[j] & 0xffff)); acc[2 * j + 1] += w * bf2f((u16)(ww[j] >> 16)); }
            }
        }
        const float inv = 1.0f / wsum;
        uint4 o; o.x = pk2(acc[0] * inv, acc[1] * inv); o.y = pk2(acc[2] * inv, acc[3] * inv); o.z = pk2(acc[4] * inv, acc[5] * inv); o.w = pk2(acc[6] * inv, acc[7] * inv);
        *(uint4*)(YA + th * 64 + pc * 8) = o;
    }
}

__device__ __forceinline__ void phase_merge(const Params& p, unsigned char* smem, int bid, int nb) {
    const u16* PROJ = (const u16*)(p.ws + WS_PROJ); u16* MG = (u16*)(p.ws + WS_MERGED);
    {
        pg8::Gemm g{(const u16*)(p.ws + WS_YA), (const u16*)(p.ws + WS_WTPA), T, 1024, 512};
        pg8::StaticOrder S; S.init(T, 1024, nb, bid);
        EpiMerge<0> E{MG, PROJ};
        pg8::gemm_phase<EpiMerge<0>, pg8::StaticOrder, false, true>((LAS unsigned char*)smem, g, S, E);
    }
    {
        pg8::Gemm g{(const u16*)(p.ws + WS_YR), (const u16*)(p.ws + WS_WTPR), T, 1024, 1024};
        pg8::StaticOrder S; S.init(T, 1024, nb, bid);
        EpiMerge<1> E{MG, PROJ};
        pg8::gemm_phase<EpiMerge<1>, pg8::StaticOrder, false, true>((LAS unsigned char*)smem, g, S, E);
    }
}

__device__ __forceinline__ void phase_outproj(const Params& p, unsigned char* smem, int bid, int nb) {
    pg8::Gemm g{(const u16*)(p.ws + WS_MERGED), (const u16*)(p.ws + WS_WTOUT), T, 1024, 1024};
    pg8::StaticOrder S; S.init(T, 1024, nb, bid);
    EpiOut E{p.x, (const float*)(p.ws + WS_MOD), (float*)(p.ws + WS_X1)};
    pg8::gemm_phase<EpiOut, pg8::StaticOrder, false, true>((LAS unsigned char*)smem, g, S, E);
}

__device__ __forceinline__ void phase_router_gemm(const Params& p, unsigned char* smem, int bid, int nb) {
    pg8::Gemm g{(const u16*)(p.ws + WS_H2), (const u16*)(p.ws + WS_WTRT), T, 768, D};
    pg8::StaticOrder S; S.init(T, 768, nb, bid);
    EpiRouterShared E{(float*)(p.ws + WS_LOGIT), (u16*)(p.ws + WS_GSH)};
    pg8::gemm_phase<EpiRouterShared, pg8::StaticOrder, false, true>((LAS unsigned char*)smem, g, S, E);
}

__device__ __forceinline__ void phase_route_shared(const Params& p, unsigned char* smem, int bid, int nb) {
    const int tid = opaque_tid(), lane = tid & 63, wid = tid >> 6;
    const float* LG = (const float*)(p.ws + WS_LOGIT);
    unsigned* ecnt = (unsigned*)(p.ws + WS_CTL + 20480);
    unsigned* elist = (unsigned*)(p.ws + WS_ELIST); float* WTS = (float*)(p.ws + WS_WTS);
    unsigned* lcnt = (unsigned*)smem;
    unsigned* lbase = lcnt + 256;
    int* sel_e = (int*)(lbase + 256);
    unsigned* sel_p = (unsigned*)(sel_e + 512);
    for (int chunk = bid; chunk < T / 64; chunk += nb) {
        if (tid < 256) lcnt[tid] = 0u;
        __syncthreads();
        {
            const float4 bs = *(const float4*)(p.router_bias + lane * 4);
            const unsigned long long ltm = (1ull << lane) - 1ull;
#pragma unroll 2
            for (int rr = 0; rr < 8; ++rr) {
                const int tl = wid * 8 + rr, token = chunk * 64 + tl;
                const float4 lg = *(const float4*)(LG + (size_t)token * 256 + lane * 4);
                const float sc0 = sigmoidf_(lg.x), sc1 = sigmoidf_(lg.y), sc2 = sigmoidf_(lg.z), sc3 = sigmoidf_(lg.w);
                const float c0 = sc0 + bs.x, c1 = sc1 + bs.y, c2 = sc2 + bs.z, c3 = sc3 + bs.w;
                float m1 = fmaxf(fmaxf(c0, c1), fmaxf(c2, c3)), m2;
                {
                    const float a = fmaxf(c0, c1), a2 = fminf(c0, c1), bq = fmaxf(c2, c3), b2 = fminf(c2, c3);
                    m2 = fmaxf(fminf(a, bq), fmaxf(a2, b2));
                }
#pragma unroll
                for (int o = 1; o <= 4; o <<= 1) {
                    const float o1 = __shfl_xor(m1, o), o2 = __shfl_xor(m2, o);
                    const float n1 = fmaxf(m1, o1), n2 = fmaxf(fminf(m1, o1), fmaxf(m2, o2));
                    m1 = n1; m2 = n2;
                }
                const float gs = m1 + m2; const int grp = lane >> 3;
                int grank = 0;
#pragma unroll
                for (int g = 0; g < 8; ++g) { const float og = __shfl(gs, g * 8); grank += (og > gs || (og == gs && g < grp)) ? 1 : 0; }
                const bool gsel = grank < 4;
                unsigned k0, k1, k2, k3;
                { unsigned u = __float_as_uint(c0); k0 = gsel ? ((u & 0x80000000u) ? ~u : (u | 0x80000000u)) : 0u; }
                { unsigned u = __float_as_uint(c1); k1 = gsel ? ((u & 0x80000000u) ? ~u : (u | 0x80000000u)) : 0u; }
                { unsigned u = __float_as_uint(c2); k2 = gsel ? ((u & 0x80000000u) ? ~u : (u | 0x80000000u)) : 0u; }
                { unsigned u = __float_as_uint(c3); k3 = gsel ? ((u & 0x80000000u) ? ~u : (u | 0x80000000u)) : 0u; }
                unsigned cur = 0u;
#pragma unroll
                for (int bb = 31; bb >= 0; --bb) {
                    const unsigned cand = cur | (1u << bb);
                    const int cn = __popcll(__ballot(k0 >= cand)) + __popcll(__ballot(k1 >= cand)) + __popcll(__ballot(k2 >= cand)) + __popcll(__ballot(k3 >= cand));
                    cur = (cn >= 8) ? cand : cur;
                }
                const int need = 8 - (__popcll(__ballot(k0 > cur)) + __popcll(__ballot(k1 > cur)) + __popcll(__ballot(k2 > cur)) + __popcll(__ballot(k3 > cur)));
                const bool e0 = k0 == cur, e1 = k1 == cur, e2 = k2 == cur, e3 = k3 == cur;
                const int eqb = __popcll(__ballot(e0) & ltm) + __popcll(__ballot(e1) & ltm) + __popcll(__ballot(e2) & ltm) + __popcll(__ballot(e3) & ltm);
                const bool s0 = (k0 > cur) || (e0 && eqb < need);
                const bool s1 = (k1 > cur) || (e1 && eqb + (e0 ? 1 : 0) < need);
                const bool s2 = (k2 > cur) || (e2 && eqb + (e0 ? 1 : 0) + (e1 ? 1 : 0) < need);
                const bool s3 = (k3 > cur) || (e3 && eqb + (e0 ? 1 : 0) + (e1 ? 1 : 0) + (e2 ? 1 : 0) < need);
                const int pb = __popcll(__ballot(s0) & ltm) + __popcll(__ballot(s1) & ltm) + __popcll(__ballot(s2) & ltm) + __popcll(__ballot(s3) & ltm);
                const float ssum = wave_sum((s0 ? sc0 : 0.f) + (s1 ? sc1 : 0.f) + (s2 ? sc2 : 0.f) + (s3 ? sc3 : 0.f));
                const float rn = 2.5f / (ssum + 1e-20f);
                int pos = pb;
                if (s0) { WTS[token * 8 + pos] = sc0 * rn; sel_e[tl * 8 + pos] = lane * 4 + 0; sel_p[tl * 8 + pos] = atomicAdd(&lcnt[lane * 4 + 0], 1u); ++pos; }
                if (s1) { WTS[token * 8 + pos] = sc1 * rn; sel_e[tl * 8 + pos] = lane * 4 + 1; sel_p[tl * 8 + pos] = atomicAdd(&lcnt[lane * 4 + 1], 1u); ++pos; }
                if (s2) { WTS[token * 8 + pos] = sc2 * rn; sel_e[tl * 8 + pos] = lane * 4 + 2; sel_p[tl * 8 + pos] = atomicAdd(&lcnt[lane * 4 + 2], 1u); ++pos; }
                if (s3) { WTS[token * 8 + pos] = sc3 * rn; sel_e[tl * 8 + pos] = lane * 4 + 3; sel_p[tl * 8 + pos] = atomicAdd(&lcnt[lane * 4 + 3], 1u); ++pos; }
            }
        }
        __syncthreads();
        if (tid < 256) lbase[tid] = lcnt[tid] ? atomicAdd(&ecnt[tid * ECNT_STRIDE], lcnt[tid]) : 0u;
        __syncthreads();
        {
            const int e = sel_e[tid];
            elist[(size_t)e * T + lbase[e] + sel_p[tid]] = (unsigned)((chunk * 64 + (tid >> 3)) * 8 + (tid & 7));
        }
        __syncthreads();
    }
}

__device__ __forceinline__ unsigned cvt_pk_bf16_f32(float lo, float hi) { unsigned r; asm("v_cvt_pk_bf16_f32 %0, %1, %2" : "=v"(r) : "v"(lo), "v"(hi)); return r; }

constexpr int EX_STG = 32768 + WB_TILE_BYTES;
constexpr int EX_TAB = 2 * EX_STG;

__device__ __forceinline__ void phase_experts(const Params& p, unsigned char* smem, int bid, int nb) {
    const int tid = opaque_tid(), lane = tid & 63, wid = __builtin_amdgcn_readfirstlane(tid >> 6), wm = wid & 1, wn = wid >> 1, fr = lane & 15, fq = lane >> 4;
    const unsigned char* Hb = (const unsigned char*)(p.ws + WS_H2);
    const unsigned* ecnt = (const unsigned*)(p.ws + WS_CTL + 20480);
    const unsigned* elist = (const unsigned*)(p.ws + WS_ELIST); const float* WTS = (const float*)(p.ws + WS_WTS);
    u16* OS = (u16*)(p.ws + WS_OSLOT);
    unsigned char* Gb = p.ws + WS_GBUF + (size_t)bid * 131072;
    int* pref = (int*)(smem + EX_TAB);
    int* rowtok = pref + 260;
    int* rowslot = rowtok + 256;
    float* roww = (float*)(rowslot + 256);
    int* ordk = (int*)(smem + EX_TAB + 5152);
    int* cntL = ordk + 256;
    {
        int nrb4[4], kmin4[4], k4[4]; float x4[4];
        float fs = 0.f, fk = 0.f;
#pragma unroll
        for (int j = 0; j < 4; ++j) { const int c = (int)ecnt[(lane + 64 * j) * ECNT_STRIDE]; nrb4[j] = (c + 31) >> 5; kmin4[j] = (nrb4[j] + 7) >> 3; fs += (float)nrb4[j]; fk += (float)kmin4[j]; }
        const float tot = wave_sum(fs); const int KM = (int)wave_sum(fk);
        const int R = (KM + nb - 1) / nb; const float target = (float)(R * nb - (nb >= 128 ? 40 : 0));
        const float scale = target / fmaxf(tot, 1.f);
#pragma unroll
        for (int j = 0; j < 4; ++j) x4[j] = (float)nrb4[j] * scale;
        float lo = -1.f;
        {
            float sv = 0.f;
#pragma unroll
            for (int j = 0; j < 4; ++j) sv += (float)max(kmin4[j], (int)x4[j]);
            if (wave_sum(sv) <= target) lo = 0.f;
        }
        if (lo >= 0.f) {
            float hi = 1.f;
            for (int it = 0; it < 12; ++it) {
                const float mid = 0.5f * (lo + hi);
                float sv = 0.f;
#pragma unroll
                for (int j = 0; j < 4; ++j) sv += (float)max(kmin4[j], (int)(x4[j] + mid));
                if (wave_sum(sv) <= target) lo = mid; else hi = mid;
            }
        }
#pragma unroll
        for (int j = 0; j < 4; ++j) k4[j] = (lo >= 0.f) ? max(kmin4[j], (int)(x4[j] + lo)) : kmin4[j];
        if (wid == 0) {
#pragma unroll
            for (int j = 0; j < 4; ++j) rowtok[lane + 64 * j] = (k4[j] << 8) | (k4[j] > 0 ? (nrb4[j] + k4[j] - 1) / k4[j] : 0);
        }
        __syncthreads();
        int my = 0, rank = 0;
        if (tid < 256) {
            my = rowtok[tid]; const int mt = my & 255;
            for (int o = 0; o < 256; ++o) { const int ot = rowtok[o] & 255; rank += (ot > mt || (ot == mt && o < tid)) ? 1 : 0; }
        }
        __syncthreads();
        if (tid < 256) { ordk[rank] = tid | (my & ~255); cntL[tid] = (int)ecnt[tid * ECNT_STRIDE]; }
        __syncthreads();
        if (tid < 256) pref[tid + 1] = ordk[tid] >> 8;
        if (tid == 0) pref[0] = 0;
        __syncthreads();
        for (int off = 1; off < 256; off <<= 1) {
            int v = 0;
            if (tid < 256) v = pref[tid + 1] + ((tid >= off) ? pref[tid + 1 - off] : 0);
            __syncthreads();
            if (tid < 256) pref[tid + 1] = v;
            __syncthreads();
        }
    }
    const int total = __builtin_amdgcn_readfirstlane(pref[256]);
    const unsigned lds0 = (unsigned)(unsigned long long)(LAS unsigned char*)smem;
    const int whalf = wid & 1, wrow0 = (wid >> 1) * 16, sc4 = lane & 31, lrow = lane >> 5;
    const unsigned wvoff1 = (unsigned)(lrow * 256 + sc4 * 4) * 4u, wvoff2 = (unsigned)(lrow * 1024 + sc4 * 4) * 4u;
    const int o4_ = whalf * 32 + sc4, l4_ = (o4_ >> 3) * 8 + (o4_ & 1) * 4 + ((o4_ >> 1) & 3);
    const int cb1 = ((sc4 >> 2) * 32 + (sc4 & 3) * 4 + whalf * 16) * 2, cb2 = l4_ * 8;
    const int wl1 = (wrow0 + lrow) * WB_PITCH + cb1, wl1x = (wrow0 + lrow) * WB_PITCH + (cb1 ^ 128);
    const int wl2 = (wrow0 + lrow) * WB_PITCH + cb2, wl2x = (wrow0 + lrow) * WB_PITCH + (cb2 ^ 128);
    const int lsub = lane >> 3, lpp = lane & 7, csrc = lpp ^ lsub;
    const int ii = lane & 15;
    const int wboff = (8 * fq + (ii >> 2)) * WB_PITCH + ((wn ^ (fq & 1)) * 128) + (ii & 3) * 8;
    const int a0off = swz_off(wm * 16 + fr, fq), a1off = swz_off(wm * 16 + fr, 4 + fq);
#define EX_ISSUE_A(s, stg, G2) do { const int kt_ = (G2) ? (((s) - 32) & 3) : ((s) & 15); \
        if (G2) { const unsigned char* ub_ = (const unsigned char*)Gb + kt_ * 128; unsigned vo_ = aoffG0; asm volatile("" : "+v"(vo_)); \
            _Pragma("unroll") for (int i_ = 0; i_ < 4; ++i_) if ((i_ * 8 + wid) * 8 < nmi * 32) \
                __builtin_amdgcn_global_load_lds((const unsigned*)(ub_ + i_ * 32768 + vo_), (LAS unsigned*)(smem + (stg) * EX_STG + (i_ * 8 + wid) * 1024), 16, 0, 0); } \
        else { const unsigned char* ub_ = Hb + kt_ * 128; \
            _Pragma("unroll") for (int i_ = 0; i_ < 4; ++i_) if ((i_ * 8 + wid) * 8 < nmi * 32) \
                __builtin_amdgcn_global_load_lds((const unsigned*)(ub_ + aoffH[i_]), (LAS unsigned*)(smem + (stg) * EX_STG + (i_ * 8 + wid) * 1024), 16, 0, 0); } } while (0)
#define EX_LOAD_W(s) do { const bool g2_ = (s) >= 32; const int kt_ = g2_ ? (((s) - 32) & 3) : ((s) & 15); const int ps_ = g2_ ? (((s) - 32) >> 2) : ((s) >> 4); \
        const unsigned char* ub_ = g2_ ? (const unsigned char*)(W2 + ps_ * 256 + whalf * 128 + (size_t)(kt_ * 64 + wrow0) * 1024) : (const unsigned char*)(W13u + ps_ * 128 + (size_t)(kt_ * 64 + wrow0) * 256); \
        const unsigned vo_ = g2_ ? wvoff2 : wvoff1; const int ld2_ = g2_ ? 8192 : 2048; \
        _Pragma("unroll") for (int i_ = 0; i_ < 8; ++i_) rw[i_] = *(const f32x4*)(ub_ + (size_t)i_ * ld2_ + vo_); } while (0)
#define EX_ISSUE_A1(i_, s, stg, G2) do { const int kt_ = (G2) ? (((s) - 32) & 3) : ((s) & 15); \
        if ((i_ * 8 + wid) * 8 < nmi * 32) { \
            if (G2) __builtin_amdgcn_global_load_lds((const unsigned*)((const unsigned char*)Gb + kt_ * 128 + i_ * 32768 + aoffG0), (LAS unsigned*)(smem + (stg) * EX_STG + (i_ * 8 + wid) * 1024), 16, 0, 0); \
            else __builtin_amdgcn_global_load_lds((const unsigned*)(Hb + kt_ * 128 + aoffH[i_]), (LAS unsigned*)(smem + (stg) * EX_STG + (i_ * 8 + wid) * 1024), 16, 0, 0); } \
        else if ((i_) < 2) __builtin_amdgcn_global_load_lds((const unsigned*)Hb, (LAS unsigned*)(smem + EX_TAB + 4128), 16, 0, 0); } while (0)
#define EX_LOAD_W1(i_, s) do { const bool g2_ = (s) >= 32; const int kt_ = g2_ ? (((s) - 32) & 3) : ((s) & 15); const int ps_ = g2_ ? (((s) - 32) >> 2) : ((s) >> 4); \
        const unsigned char* ub_ = g2_ ? (const unsigned char*)(W2 + ps_ * 256 + whalf * 128 + (size_t)(kt_ * 64 + wrow0) * 1024) : (const unsigned char*)(W13u + ps_ * 128 + (size_t)(kt_ * 64 + wrow0) * 256); \
        const unsigned vo_ = g2_ ? wvoff2 : wvoff1; const unsigned char* sb_ = ub_ + (size_t)(i_) * (g2_ ? 8192 : 2048); \
        asm volatile("s_nop 4\n\tglobal_load_dwordx4 %0, %1, %2" : "=v"(rw[i_]) : "v"(vo_), "s"(sb_) : "memory"); } while (0)
#define EX_STORE_W1(j_, t, stg) do { const unsigned wa_ = lds0 + (unsigned)((stg) * EX_STG + 32768 + (2 * (j_)) * WB_PITCH) + (unsigned)((j_) < 4 ? (((t) >= 32) ? wl2 : wl1) : (((t) >= 32) ? wl2x : wl1x)); \
        uint2 w_; w_.x = cvt_pk_bf16_f32(rw[j_][0], rw[j_][1]); w_.y = cvt_pk_bf16_f32(rw[j_][2], rw[j_][3]); \
        asm volatile("ds_write_b64 %0, %1" :: "v"(wa_), "v"(w_) : "memory"); } while (0)
#define EX_STORE_W(s, stg) do { unsigned char* wt_ = smem + (stg) * EX_STG + 32768; int lo_ = ((s) >= 32) ? wl2 : wl1, hi_ = ((s) >= 32) ? wl2x : wl1x; asm volatile("" : "+v"(lo_), "+v"(hi_)); \
        _Pragma("unroll") for (int i_ = 0; i_ < 8; ++i_) { uint2 w_; w_.x = cvt_pk_bf16_f32(rw[i_][0], rw[i_][1]); w_.y = cvt_pk_bf16_f32(rw[i_][2], rw[i_][3]); \
            *(uint2*)(wt_ + (i_ < 4 ? lo_ : hi_) + (2 * i_) * WB_PITCH) = w_; } } while (0)
    const int vcx = vcu_of(bid, nb);
    for (int rnd = 0; rnd * nb < total; ++rnd) {
        const int item = rnd * nb + (rnd == 0 ? vcx : nb - 1 - vcx);
        if (item >= total) continue;
        int e, ntile, tile;
        {
            int lo = 0, hi = 256;
            while (hi - lo > 1) { const int mid = (lo + hi) >> 1; if (pref[mid] <= item) lo = mid; else hi = mid; }
            lo = __builtin_amdgcn_readfirstlane(lo);
            const int ok = __builtin_amdgcn_readfirstlane(ordk[lo]);
            e = ok & 255; ntile = ok >> 8; tile = item - __builtin_amdgcn_readfirstlane(pref[lo]);
        }
        const int cnt = __builtin_amdgcn_readfirstlane(cntL[e]), nrb = (cnt + 31) >> 5, rbb = nrb / ntile, rbx = nrb - rbb * ntile;
        const int rb0 = tile * rbb + min(tile, rbx), nmi = rbb + (tile < rbx ? 1 : 0);
        const int r_lo = rb0 * 32, nrows = min(cnt - r_lo, nmi * 32);
        const float* W1 = p.w1 + (size_t)e * 1024 * 256;
        const float* W3 = p.w3 + (size_t)e * 1024 * 256;
        const float* W2 = p.w2 + (size_t)e * 256 * 1024;
        const float* W13u = whalf ? W3 : W1;
        f32x4 rw[8];
        EX_LOAD_W(0);
        unsigned rid = 0u;
        if (tid < 256) {
            if (tid < nrows) { rid = elist[(size_t)e * T + r_lo + tid]; rowtok[tid] = (int)(rid >> 3); rowslot[tid] = (int)rid; }
            else { rowtok[tid] = 0; rowslot[tid] = -1; }
        }
        __syncthreads();
        float rwt = 0.f;
        if (tid < nrows && tid < 256) rwt = WTS[rid];
        unsigned aoffH[4];
#pragma unroll
        for (int i = 0; i < 4; ++i) { const int r = (i * 8 + wid) * 8 + lsub; aoffH[i] = (unsigned)rowtok[r] * 2048u + csrc * 16; }
        const unsigned aoffG0 = (unsigned)(wid * 8 + lsub) * 512u + csrc * 16;
        f32x4 acc[8][4];
#pragma unroll
        for (int a = 0; a < 8; ++a)
#pragma unroll
            for (int c = 0; c < 4; ++c) acc[a][c] = (f32x4){0.f, 0.f, 0.f, 0.f};
        EX_ISSUE_A(0, 0, false); EX_STORE_W(0, 0);
        if (tid < 256) roww[tid] = rwt;
        { _Pragma("unroll") for (int j_ = 0; j_ < 8; ++j_) EX_LOAD_W1(j_, 1); }
        asm volatile("s_waitcnt vmcnt(8)" ::: "memory");
        __syncthreads();
#define EX_STEP(s, HASNEXT, NOA, G2) do { const int cur_ = (s) & 1, nxt_ = cur_ ^ 1; const int t2_ = ((s) + 2 < 48) ? (s) + 2 : 47; \
            { int wb_ = wboff, ao0_ = a0off, ao1_ = a1off; asm volatile("" : "+v"(wb_), "+v"(ao0_), "+v"(ao1_)); const unsigned char* As_ = smem + cur_ * EX_STG; \
              const unsigned wsa_ = lds0 + (unsigned)(cur_ * EX_STG + 32768) + (unsigned)wb_; \
              _Pragma("unroll") for (int ks_ = 0; ks_ < 2; ++ks_) { bf16x8 bfr_[4]; \
                { bf16x4 tl_[4], th_[4]; \
                  TR_READ_ASM(tl_[0], wsa_, ks_ * 32 * WB_PITCH + 0); TR_READ_ASM(th_[0], wsa_, (ks_ * 32 + 4) * WB_PITCH + 0); \
                  TR_READ_ASM(tl_[1], wsa_, ks_ * 32 * WB_PITCH + 32); TR_READ_ASM(th_[1], wsa_, (ks_ * 32 + 4) * WB_PITCH + 32); \
                  TR_READ_ASM(tl_[2], wsa_, ks_ * 32 * WB_PITCH + 64); TR_READ_ASM(th_[2], wsa_, (ks_ * 32 + 4) * WB_PITCH + 64); \
                  TR_READ_ASM(tl_[3], wsa_, ks_ * 32 * WB_PITCH + 96); TR_READ_ASM(th_[3], wsa_, (ks_ * 32 + 4) * WB_PITCH + 96); \
                  asm volatile("s_waitcnt lgkmcnt(0)" : "+v"(tl_[0]), "+v"(tl_[1]), "+v"(tl_[2]), "+v"(tl_[3]), "+v"(th_[0]), "+v"(th_[1]), "+v"(th_[2]), "+v"(th_[3]) :: "memory"); \
                  __builtin_amdgcn_sched_barrier(0); \
                  _Pragma("unroll") for (int ni_ = 0; ni_ < 4; ++ni_) bfr_[ni_] = (bf16x8){tl_[ni_][0], tl_[ni_][1], tl_[ni_][2], tl_[ni_][3], th_[ni_][0], th_[ni_][1], th_[ni_][2], th_[ni_][3]}; } \
                _Pragma("unroll") for (int mi_ = 0; mi_ < 8; ++mi_) { if (mi_ < 4 || mi_ < nmi) { const bf16x8 af_ = *(const bf16x8*)(As_ + (ks_ ? ao1_ : ao0_) + mi_ * 4096);        \
                    _Pragma("unroll") for (int ni_ = 0; ni_ < 4; ++ni_) acc[mi_][ni_] = __builtin_amdgcn_mfma_f32_16x16x32_bf16(bfr_[ni_], af_, acc[mi_][ni_], 0, 0, 0); } \
                      \
                    if (ks_ * 8 + mi_ < 4) { if ((HASNEXT) && !(NOA)) EX_ISSUE_A1(ks_ * 8 + mi_, (s) + 1, nxt_, G2); else if (ks_ * 8 + mi_ < 2) __builtin_amdgcn_global_load_lds((const unsigned*)Hb, (LAS unsigned*)(smem + EX_TAB + 4128), 16, 0, 0); } \
                    else if (ks_ * 8 + mi_ < 12) { asm volatile("s_waitcnt vmcnt(9)" : "+v"(rw[ks_ * 8 + mi_ - 4]) :: "memory"); EX_STORE_W1(ks_ * 8 + mi_ - 4, (s) + 1, nxt_); EX_LOAD_W1(ks_ * 8 + mi_ - 4, t2_); } \
                    __builtin_amdgcn_sched_barrier(0); } } } \
            asm volatile("s_waitcnt vmcnt(8)" ::: "memory"); \
            asm volatile("s_waitcnt lgkmcnt(0)" ::: "memory"); \
            __builtin_amdgcn_s_barrier(); \
            asm volatile("" ::: "memory"); } while (0)
        int s = 0;
#pragma unroll 1
        for (int ps = 0; ps < 2; ++ps) {
#pragma unroll 1
            for (int kt = 0; kt < 16; ++kt, ++s) EX_STEP(s, true, false, s == 31);
            int frg = fr, fqg = fq; asm volatile("" : "+v"(frg), "+v"(fqg));
#pragma unroll
            for (int mi = 0; mi < 8; ++mi) {
                if (mi < nmi) {
                    const int row = (2 * mi + wm) * 16 + frg;
#pragma unroll
                    for (int pr = 0; pr < 2; ++pr) {
                        float g[4];
#pragma unroll
                        for (int j = 0; j < 4; ++j) g[j] = siluf_(acc[mi][2 * pr][j]) * acc[mi][2 * pr + 1][j];
                        uint2 w; w.x = cvt_pk_bf16_f32(g[0], g[1]); w.y = cvt_pk_bf16_f32(g[2], g[3]);
                        *(uint2*)(Gb + (size_t)row * 512 + (ps * 128 + wn * 32 + pr * 16 + 4 * fqg) * 2) = w;
                    }
                }
#pragma unroll
                for (int c = 0; c < 4; ++c) acc[mi][c] = (f32x4){0.f, 0.f, 0.f, 0.f};
            }
        }
#pragma unroll 1
        for (int ps = 0; ps < 4; ++ps) {
#pragma unroll 1
            for (int kt = 0; kt < 4; ++kt, ++s) EX_STEP(s, s < 47, false, true);
            int fro = fr, fqo = fq; asm volatile("" : "+v"(fro), "+v"(fqo));
#pragma unroll
            for (int mi = 0; mi < 8; ++mi) {
                if (mi < nmi) {
                    const int row = (2 * mi + wm) * 16 + fro;
                    const int slot = rowslot[row]; const float w = roww[row];
                    if (slot >= 0) {
#pragma unroll
                        for (int hh = 0; hh < 2; ++hh) {
                            uint4 o;
                            o.x = cvt_pk_bf16_f32(acc[mi][2 * hh][0] * w, acc[mi][2 * hh][1] * w); o.y = cvt_pk_bf16_f32(acc[mi][2 * hh][2] * w, acc[mi][2 * hh][3] * w);
                            o.z = cvt_pk_bf16_f32(acc[mi][2 * hh + 1][0] * w, acc[mi][2 * hh + 1][1] * w); o.w = cvt_pk_bf16_f32(acc[mi][2 * hh + 1][2] * w, acc[mi][2 * hh + 1][3] * w);
                            *(uint4*)(OS + (size_t)slot * 1024 + ps * 256 + wn * 64 + hh * 32 + 8 * fqo) = o;
                        }
                    }
                }
#pragma unroll
                for (int c = 0; c < 4; ++c) acc[mi][c] = (f32x4){0.f, 0.f, 0.f, 0.f};
                asm volatile("" ::: "memory");
            }
        }
        asm volatile("s_waitcnt vmcnt(0)" ::: "memory");
        __syncthreads();
#undef EX_STEP
#undef EX_ISSUE_A1
#undef EX_LOAD_W1
#undef EX_ISSUE_A
#undef EX_LOAD_W
#undef EX_STORE_W
    }
    {
        __syncthreads();
        const int vc = vcu_of(bid, nb), rem = total % nb;
        int G2 = nb, c2 = vc;
        if (rem != 0 && nb - rem >= 32) { G2 = nb - rem; c2 = (total < nb) ? vc - rem : (vc < nb - rem ? vc : -1); }
        if (c2 >= 0) {
            pg8::Gemm g{(const u16*)(p.ws + WS_GSH), (const u16*)(p.ws + WS_WTS2), T, 1024, 256};
            pg8::StaticOrder S; S.init(T, 1024, G2, c2);
            EpiSharedOut E{(u16*)(p.ws + WS_OSLOT)};
            pg8::gemm_phase<EpiSharedOut, pg8::StaticOrder, false, true>((LAS unsigned char*)smem, g, S, E);
        }
    }
}

__device__ __forceinline__ void phase_final(const Params& p, int bid, int nb) {
    const int tid_ = opaque_tid(); const int lane = tid_ & 63, gw = bid * (NT / 64) + (tid_ >> 6), nw = nb * (NT / 64);
    const float* X1 = (const float*)(p.ws + WS_X1); const u16* OS = (const u16*)(p.ws + WS_OSLOT); const float* mod = (const float*)(p.ws + WS_MOD);
    float4 gfin[4], gt2v[4];
#pragma unroll
    for (int i = 0; i < 4; ++i) gfin[i] = *(const float4*)(p.g_final + ((i >> 1) * 64 + lane) * 8 + (i & 1) * 4);
    int curb = -1;
    for (int row = gw; row < T; row += nw) {
        const int bt = row >= SEQ ? 1 : 0;
        if (bt != curb) {
            curb = bt;
#pragma unroll
            for (int i = 0; i < 4; ++i) gt2v[i] = *(const float4*)(mod + bt * 6144 + 5120 + ((i >> 1) * 64 + lane) * 8 + (i & 1) * 4);
        }
        float v[16]; float ss = 0.f;
#pragma unroll
        for (int i = 0; i < 2; ++i) {
            const int col = (i * 64 + lane) * 8;
            float a[8] = {0.f, 0.f, 0.f, 0.f, 0.f, 0.f, 0.f, 0.f};
#pragma unroll
            for (int k = 0; k < 9; ++k) {
                const size_t srow = (k < 8) ? ((size_t)row * 8 + k) : ((size_t)T * 8 + row);
                const uint4 w = *(const uint4*)(OS + srow * 1024 + col);
                a[0] += bf2f((u16)(w.x & 0xffff)); a[1] += bf2f((u16)(w.x >> 16)); a[2] += bf2f((u16)(w.y & 0xffff)); a[3] += bf2f((u16)(w.y >> 16));
                a[4] += bf2f((u16)(w.z & 0xffff)); a[5] += bf2f((u16)(w.z >> 16)); a[6] += bf2f((u16)(w.w & 0xffff)); a[7] += bf2f((u16)(w.w >> 16));
            }
            const float4 x0 = *(const float4*)(X1 + (size_t)row * D + col), x1v = *(const float4*)(X1 + (size_t)row * D + col + 4);
            const float4 g0 = gt2v[i * 2], g1 = gt2v[i * 2 + 1];
            v[i * 8 + 0] = x0.x + g0.x * a[0]; v[i * 8 + 1] = x0.y + g0.y * a[1]; v[i * 8 + 2] = x0.z + g0.z * a[2]; v[i * 8 + 3] = x0.w + g0.w * a[3];
            v[i * 8 + 4] = x1v.x + g1.x * a[4]; v[i * 8 + 5] = x1v.y + g1.y * a[5]; v[i * 8 + 6] = x1v.z + g1.z * a[6]; v[i * 8 + 7] = x1v.w + g1.w * a[7];
#pragma unroll
            for (int j = 0; j < 8; ++j) ss += v[i * 8 + j] * v[i * 8 + j];
        }
        ss = wave_sum(ss);
        const float rstd = rsqrtf(ss * (1.0f / D) + 1e-6f);
#pragma unroll
        for (int i = 0; i < 2; ++i) {
            const int col = (i * 64 + lane) * 8;
            const float4 gg0 = gfin[i * 2], gg1 = gfin[i * 2 + 1];
            float4 o0, o1;
            o0.x = v[i * 8 + 0] * rstd * gg0.x; o0.y = v[i * 8 + 1] * rstd * gg0.y; o0.z = v[i * 8 + 2] * rstd * gg0.z; o0.w = v[i * 8 + 3] * rstd * gg0.w;
            o1.x = v[i * 8 + 4] * rstd * gg1.x; o1.y = v[i * 8 + 5] * rstd * gg1.y; o1.z = v[i * 8 + 6] * rstd * gg1.z; o1.w = v[i * 8 + 7] * rstd * gg1.w;
            *(float4*)(p.out + (size_t)row * D + col) = o0;
            *(float4*)(p.out + (size_t)row * D + col + 4) = o1;
        }
    }
}

constexpr int LDS_BYTES = 73728 + 65536 + 4096;


#define XB_TMO      128
#define XB_XCNT(j)  (256  + 64 * (j))
#define XB_XSUB(j)  (1280 + 64 * (j))
#define XB_XGEN(j)  (2304 + 64 * (j))
#define XB_TOP      3328
#define XB_TOPGEN   3392
#define XCD_BAR_WORDS 3456
#define XB_SPIN_CAP (1u << 18)
__device__ __forceinline__ unsigned xb_ld(unsigned* p)              { return __hip_atomic_load(p, __ATOMIC_RELAXED, __HIP_MEMORY_SCOPE_AGENT); }
__device__ __forceinline__ unsigned xb_add(unsigned* p, unsigned v) { return __hip_atomic_fetch_add(p, v, __ATOMIC_RELAXED, __HIP_MEMORY_SCOPE_AGENT); }
__device__ __forceinline__ unsigned xb_xcc_id() { return (unsigned)__builtin_amdgcn_s_getreg((3 << 11) | 20) & 0xFu; }
#define XB_SPIN(cond, bar) do { unsigned _sp = 0; while (cond) { __builtin_amdgcn_s_sleep(1); \
    if ((++_sp & 255u) == 0u) { if (xb_ld(&(bar)[XB_TMO])) break; if (_sp > XB_SPIN_CAP) { atomicAdd(&(bar)[XB_TMO], 1u); break; } } } } while (0)
struct XcdBarrier { unsigned* bar; unsigned x; volatile LAS unsigned* st; };
__device__ __forceinline__ XcdBarrier xcd_barrier_post(unsigned* bar, volatile LAS unsigned* st) {
    XcdBarrier b; b.bar = bar; b.x = xb_xcc_id(); b.st = st;
    if (threadIdx.x == 0) (void)xb_add(&bar[XB_XCNT(b.x)], 1u);
    return b;
}
__device__ __forceinline__ void xcd_barrier_complete(unsigned* bar, unsigned x, unsigned& nloc, unsigned& nx) {
    const unsigned G = gridDim.x * gridDim.y * gridDim.z;
    unsigned sum, cnt, mine, sp = 0u;
    for (;;) {
        sum = 0u; cnt = 0u; mine = 0u;
#pragma unroll
        for (unsigned j = 0; j < 16; ++j) { const unsigned c = xb_ld(&bar[XB_XCNT(j)]); sum += c; cnt += (c > 0u) ? 1u : 0u; mine = (j == x) ? c : mine; }
        if (sum == G) break;
        __builtin_amdgcn_s_sleep(1);
        if ((++sp & 255u) == 0u) { if (xb_ld(&bar[XB_TMO])) break; if (sp > XB_SPIN_CAP) { atomicAdd(&bar[XB_TMO], 1u); break; } }
    }
    nloc = mine > 0u ? mine : 1u; nx = cnt > 0u ? cnt : 1u;
}
__device__ __forceinline__ void xcd_barrier(const XcdBarrier& b) {
    asm volatile("s_waitcnt vmcnt(0)" ::: "memory");
    __syncthreads();
    if (threadIdx.x == 0) {
        unsigned* bar = b.bar;
        __builtin_amdgcn_s_waitcnt(0);
        unsigned nloc = b.st[0], nx = b.st[1]; const unsigned gen = b.st[2];
        if (nloc == 0u) { xcd_barrier_complete(bar, b.x, nloc, nx); b.st[0] = nloc; b.st[1] = nx; }
        __builtin_amdgcn_fence(__ATOMIC_ACQUIRE, "agent");
        const unsigned old = xb_add(&bar[XB_XSUB(b.x)], 1u);
        if (old + 1u == (gen + 1u) * nloc) {
            __builtin_amdgcn_fence(__ATOMIC_RELEASE, "agent");
            asm volatile("s_waitcnt vmcnt(0)" ::: "memory");
            (void)xb_add(&bar[XB_TOP], 1u);
        }
        const unsigned want = (gen + 1u) * nx;
        XB_SPIN(xb_ld(&bar[XB_TOP]) < want, bar);
        b.st[2] = gen + 1u;
        asm volatile("s_waitcnt vmcnt(0)" ::: "memory");
    }
    __syncthreads();
}

#ifdef DEBUG_CHECK
__device__ __forceinline__ unsigned hash_u(unsigned x) { x ^= x >> 16; x *= 0x7feb352dU; x ^= x >> 15; x *= 0x846ca68bU; x ^= x >> 16; return x; }
__device__ __forceinline__ void phase_check(const Params& p, unsigned char* smem, int bid, int nb) {
    const int lane = threadIdx.x & 63, wid = threadIdx.x >> 6, gw = bid * (NT / 64) + wid, nw = nb * (NT / 64);
    const u16* PROJ = (const u16*)(p.ws + WS_PROJ);
    float* dbg = (float*)(p.ws + WS_CTL + 4096 + 14336);
    float* wsm = (float*)smem + wid * 2048;
    for (int sidx = gw; sidx < 768; sidx += nw) {
        const unsigned hsh = hash_u(sidx * 7919u + 13u);
        int tok = (int)(hsh % T); const int h = (int)((hsh >> 20) & 7);
        if (sidx < 64) tok = (tok & ~(SEQ - 1)) + (int)((hsh >> 8) % 1024);
        const int b = tok / SEQ, t = tok % SEQ, tb = t >> 8;
        wsm[lane] = bf2f(PROJ[(size_t)tok * NPROJ + C_QA + h * 64 + lane]);
        asm volatile("s_waitcnt lgkmcnt(0)" ::: "memory");
        const float qd = wsm[lane];
        float gate = -3e38f;
        if (lane < tb) {
            float g = 0.f;
            for (int r = 0; r < 256; ++r) {
                const u16* kp = PROJ + ((size_t)b * SEQ + lane * 256 + r) * NPROJ + C_KA + h * 64;
                float dsum = 0.f;
                for (int d = 0; d < 64; ++d) dsum += wsm[d] * bf2f(kp[d]);
                g += dsum;
            }
            gate = g * (1.0f / 256.0f);
        }
        const int nsel = tb < 3 ? tb : 3;
        int sel0 = 0, sel1 = 0, sel2 = 0;
        {
            float gg = gate;
            for (int k = 0; k < 3; ++k) {
                float bv = gg; int bi = lane;
                for (int o = 1; o < 64; o <<= 1) { const float ov = __shfl_xor(bv, o); const int oi = __shfl_xor(bi, o); if (ov > bv || (ov == bv && oi < bi)) { bv = ov; bi = oi; } }
                if (k == 0) sel0 = bi; else if (k == 1) sel1 = bi; else sel2 = bi;
                if (lane == bi) gg = -3e38f;
            }
        }
        const float slope = exp2f(-(float)(h + 1));
        float mx = -3e38f, lsum = 0.f, acc = 0.f;
        for (int k = 0; k < 4; ++k) {
            if (k < 3 && k >= nsel) continue;
            const int blk = (k == 0) ? sel0 : (k == 1) ? sel1 : (k == 2) ? sel2 : tb;
            for (int kk = 0; kk < 256; ++kk) {
                const int pos = blk * 256 + kk;
                if (pos > t) break;
                const u16* kp = PROJ + ((size_t)b * SEQ + pos) * NPROJ + C_KA + h * 64;
                const u16* vp = PROJ + ((size_t)b * SEQ + pos) * NPROJ + C_VA + h * 64;
                float sc = wave_sum(qd * bf2f(kp[lane]));
                sc = sc * 0.125f - slope * (float)(t - pos);
                const float mn = fmaxf(mx, sc), f = __expf(mx - mn), e = __expf(sc - mn);
                lsum = lsum * f + e; acc = acc * f + e * bf2f(vp[lane]); mx = mn;
            }
        }
        {
            const float ref = acc / lsum;
            const float got = bf2f(((const u16*)(p.ws + WS_YA))[(size_t)tok * 512 + h * 64 + lane]);
            const float e2 = wave_sum((got - ref) * (got - ref)), r2 = wave_sum(ref * ref);
            if (lane == 0) { atomicAdd(&dbg[0], e2); atomicAdd(&dbg[1], r2); }
        }
    }
    for (int sidx = gw; sidx < 512; sidx += nw) {
        const unsigned hsh = hash_u(sidx * 104729u + 77u);
        const int tok = (int)(hsh % T); const int h = (int)((hsh >> 20) & 7);
        const int b = tok / SEQ, t = tok % SEQ;
        const float l2g = log2_gamma(h);
        for (int d = lane; d < 64; d += 64) wsm[d] = bf2f(PROJ[(size_t)tok * NPROJ + C_QR + h * 64 + d]);
        asm volatile("s_waitcnt lgkmcnt(0)" ::: "memory");
        float o0 = 0.f, o1 = 0.f;
        for (int s0 = 0; s0 <= t; s0 += 64) {
            const int s = s0 + lane; float w = 0.f;
            if (s <= t) {
                const u16* kp = PROJ + ((size_t)b * SEQ + s) * NPROJ + C_KR + h * 64;
                float dsum = 0.f;
                for (int d = 0; d < 64; ++d) dsum += wsm[d] * bf2f(kp[d]);
                w = dsum * exp2f((float)(t - s) * l2g);
            }
            for (int j = 0; j < 64; ++j) {
                const float wj = __shfl(w, j);
                if (s0 + j <= t) {
                    const u16* vp = PROJ + ((size_t)b * SEQ + s0 + j) * NPROJ + C_VR + h * 128;
                    o0 += wj * bf2f(vp[lane]); o1 += wj * bf2f(vp[lane + 64]);
                }
            }
        }
        const float mu = wave_sum(o0 + o1) * (1.0f / 128.0f);
        const float var = wave_sum((o0 - mu) * (o0 - mu) + (o1 - mu) * (o1 - mu)) * (1.0f / 128.0f);
        const float rstd = rsqrtf(var + 1e-6f);
        const u16* GR = PROJ + (size_t)tok * NPROJ + C_GR + h * 128;
        const u16* YR = (const u16*)(p.ws + WS_YR) + (size_t)tok * 1024 + h * 128;
        const float r0 = (o0 - mu) * rstd * bf2f(GR[lane]), r1 = (o1 - mu) * rstd * bf2f(GR[lane + 64]);
        const float g0 = bf2f(YR[lane]), g1 = bf2f(YR[lane + 64]);
        const float e2 = wave_sum((g0 - r0) * (g0 - r0) + (g1 - r1) * (g1 - r1)), r2 = wave_sum(r0 * r0 + r1 * r1);
        if (lane == 0) { atomicAdd(&dbg[2], e2); atomicAdd(&dbg[3], r2); }
    }
}
__device__ __forceinline__ void phase_debug_out(const Params& p, int bid, int nb) {
    const float* dbg = (const float*)(p.ws + WS_CTL + 4096 + 14336);
    const float ea = sqrtf(dbg[0] / fmaxf(dbg[1], 1e-30f)), er = sqrtf(dbg[2] / fmaxf(dbg[3], 1e-30f));
    int la = (int)floorf(-log2f(fmaxf(ea, 1e-9f))); la = la < 0 ? 0 : (la > 8 ? 8 : la); la += 1;
    int lr = (int)floorf(-log2f(fmaxf(er, 1e-9f))); lr = lr < 0 ? 0 : (lr > 8 ? 8 : lr); lr += 1;
    const float c = sqrtf((float)(10 * la + lr - 1));
    for (size_t i = (size_t)bid * NT + threadIdx.x; i < (size_t)T * D; i += (size_t)nb * NT) p.out[i] = c;
}
#endif

__global__ void __launch_bounds__(NT) k_fused(Params p) {
    extern __shared__ __attribute__((aligned(16))) unsigned char smem[];
    const int bid = blockIdx.x, nb = gridDim.x;
    const float* mod = (const float*)(p.ws + WS_MOD);
    volatile LAS unsigned* bst = (volatile LAS unsigned*)(LAS unsigned char*)(smem + LDS_BYTES - 16);
    if (threadIdx.x < 4) bst[threadIdx.x] = 0u;
    __syncthreads();
    const XcdBarrier gbar = xcd_barrier_post((unsigned*)(p.ws + WS_CTL + 4096), bst);
#define GRID_SYNC() xcd_barrier(gbar)
    phase_prologue(p, smem, bid, nb);
    GRID_SYNC();
    phase_norm_mod(p.x, p.g_mix, mod, 0, 1024, (u16*)(p.ws + WS_H), bid, nb);
    GRID_SYNC();
    phase_proj(p, smem, bid, nb);
    GRID_SYNC();
    phase_kmean_kv(p, smem, bid, nb);
    GRID_SYNC();
    phase_gate_scan(p, smem, bid, nb);
    GRID_SYNC();
    phase_attn_ret(p, smem, bid, nb);
    GRID_SYNC();
    phase_combine(p, bid, nb);
    GRID_SYNC();
#ifdef DEBUG_CHECK
    phase_check(p, smem, bid, nb);
    GRID_SYNC();
#endif
    phase_merge(p, smem, bid, nb);
    GRID_SYNC();
    phase_outproj(p, smem, bid, nb);
    GRID_SYNC();
    phase_norm_mod((const float*)(p.ws + WS_X1), p.g_ffn, mod, 3072, 4096, (u16*)(p.ws + WS_H2), bid, nb);
    GRID_SYNC();
    phase_router_gemm(p, smem, bid, nb);
    GRID_SYNC();
    phase_route_shared(p, smem, bid, nb);
    GRID_SYNC();
    phase_experts(p, smem, bid, nb);
    GRID_SYNC();
    phase_final(p, bid, nb);
#ifdef DEBUG_CHECK
    GRID_SYNC();
    phase_debug_out(p, bid, nb);
#endif
}

extern "C" void kernel_launch(void* const* d_in, const int* in_sizes, int n_in, void* d_out, int out_size, void* d_ws, size_t ws_size, hipStream_t stream) {
    static int grid = 0;
    if (grid == 0) {
        int dev = 0, cus = 0, per_cu = 0;
        if (hipGetDevice(&dev) != hipSuccess || hipDeviceGetAttribute(&cus, hipDeviceAttributeMultiprocessorCount, dev) != hipSuccess || cus <= 0) cus = 256;
        (void)hipFuncSetAttribute((const void*)k_fused, hipFuncAttributeMaxDynamicSharedMemorySize, LDS_BYTES);
        if (hipOccupancyMaxActiveBlocksPerMultiprocessor(&per_cu, (const void*)k_fused, NT, LDS_BYTES) != hipSuccess || per_cu < 1) per_cu = 1;
        if (per_cu > 1) per_cu = 1;
        grid = cus * per_cu;
        if (n_in != 19 || out_size != T * D || ws_size < WS_END) { fprintf(stderr, "kernel_launch: unexpected sizes n_in %d out %d ws %zu (need %zu)\n", n_in, out_size, ws_size, (size_t)WS_END); grid = -1; }
    }
    if (grid < 0) return;
    Params p{};
    const float** pp = (const float**)&p;
    for (int i = 0; i < 19; ++i) pp[i] = (const float*)d_in[i];
    p.out = (float*)d_out; p.ws = (unsigned char*)d_ws;
    (void)hipMemsetAsync((char*)d_ws + WS_CTL, 0, CTL_BYTES, stream);
    void* args[] = {&p};
    hipError_t e = hipLaunchCooperativeKernel((const void*)k_fused, dim3(grid), dim3(NT), args, LDS_BYTES, stream);
    if (e != hipSuccess) fprintf(stderr, "cooperative launch failed: %s (grid %d)\n", hipGetErrorString(e), grid);
}
```

```cpp
#include <hip/hip_runtime.h>
#include <stdint.h>
#include <stdio.h>
#include <hip/hip_cooperative_groups.h>
namespace cg = cooperative_groups;

typedef unsigned short u16;
typedef short bf16x8 __attribute__((ext_vector_type(8)));
typedef short bf16x4 __attribute__((ext_vector_type(4)));
typedef float f32x4 __attribute__((ext_vector_type(4)));
#define LAS __attribute__((address_space(3)))

constexpr int NT = 512;
constexpr int T = 16384, D = 1024, SEQ = 8192, NB = 2;
constexpr int NPROJ = 6656;
constexpr int C_QA = 0, C_KA = 512, C_VA = 1024, C_QR = 1536, C_KR = 2048, C_VR = 2560, C_GR = 3584, C_GA = 4608, C_GT = 5632;
constexpr int NE = 256, TOPK = 8, FF = 256;
constexpr int NSLOT = T * TOPK + T;

constexpr size_t al256(size_t x) { return (x + 255) & ~(size_t)255; }
constexpr size_t WS_CTL = 0;
constexpr size_t CTL_BYTES = 4096 + 16384 + 32768;
constexpr int ECNT_STRIDE = 32;
constexpr size_t WS_MOD = WS_CTL + CTL_BYTES;
constexpr size_t WS_KMEAN = WS_MOD + al256(2 * 6144 * 4);
constexpr size_t WS_WTIN = WS_KMEAN + al256(2 * 8 * 32 * 64 * 4);
constexpr size_t WS_WTPA = WS_WTIN + (size_t)NPROJ * 1024 * 2;
constexpr size_t WS_WTPR = WS_WTPA + (size_t)1024 * 512 * 2;
constexpr size_t WS_WTOUT = WS_WTPR + (size_t)1024 * 1024 * 2;
constexpr size_t WS_WTRT = WS_WTOUT + (size_t)1024 * 1024 * 2;
constexpr size_t WS_WTS13 = WS_WTRT + (size_t)256 * 1024 * 2;
constexpr size_t WS_WTS2 = WS_WTS13 + (size_t)512 * 1024 * 2;
constexpr size_t WS_GSH = WS_WTS2 + (size_t)1024 * 256 * 2;
constexpr size_t WS_GBUF = WS_GSH + (size_t)T * 256 * 2;
constexpr size_t WS_X1 = WS_GBUF + (size_t)512 * 131072;
constexpr size_t WS_H = WS_X1 + (size_t)T * D * 4;
constexpr size_t WS_H2 = WS_H + (size_t)T * D * 2;
constexpr size_t WS_ALIST = WS_H2 + (size_t)T * D * 2;
constexpr int ALIST_PER_BH = 256 * 496;
constexpr size_t WS_ELIST = WS_ALIST + (size_t)16 * ALIST_PER_BH * 4;
constexpr size_t WS_WTS = WS_ELIST + (size_t)NE * T * 4;
constexpr size_t WS_LOGIT = WS_WTS + (size_t)T * 8 * 4;
constexpr size_t WS_R = WS_LOGIT + (size_t)T * 256 * 4;
constexpr size_t WS_PROJ = WS_R;
constexpr size_t WS_OPART = WS_PROJ + (size_t)T * NPROJ * 2;
constexpr size_t WS_ML = WS_OPART + (size_t)T * 8 * 4 * 64 * 2;
constexpr size_t WS_KV = WS_ML + (size_t)T * 8 * 4 * 2 * 4;
constexpr size_t WS_SPREV = WS_KV + (size_t)16 * 64 * 8192 * 4;
constexpr size_t WS_YA = WS_SPREV + (size_t)16 * 64 * 8192 * 2;
constexpr size_t WS_YR = WS_YA + (size_t)T * 512 * 2;
constexpr size_t WS_MERGED = WS_YR + (size_t)T * 1024 * 2;
constexpr size_t WS_END_MIX = WS_MERGED + (size_t)T * 1024 * 2;
constexpr size_t WS_OSLOT = WS_END_MIX;
constexpr size_t WS_END_MOE = WS_OSLOT + (size_t)NSLOT * 1024 * 2;
constexpr size_t WS_END = WS_END_MIX > WS_END_MOE ? WS_END_MIX : WS_END_MOE;

struct Params {
    const float *x, *c, *w_ada, *b_ada, *g_mix, *w_in, *w_pa, *w_pr, *w_out, *g_ffn, *w_router, *router_bias, *w1, *w3, *w2, *ws1, *ws3, *ws2, *g_final;
    float* out;
    unsigned char* ws;
};

__device__ __forceinline__ float bf2f(u16 b) { return __uint_as_float(((unsigned)b) << 16); }
__device__ __forceinline__ u16 f2bf(float f) { unsigned u = __float_as_uint(f); u += 0x7fffu + ((u >> 16) & 1u); return (u16)(u >> 16); }
__device__ __forceinline__ unsigned pk2(float lo, float hi) { unsigned r; asm("v_cvt_pk_bf16_f32 %0, %1, %2" : "=v"(r) : "v"(lo), "v"(hi)); return r; }
__device__ __forceinline__ float sigmoidf_(float x) { return __builtin_amdgcn_rcpf(1.0f + __builtin_amdgcn_exp2f(x * -1.44269504f)); }
__device__ __forceinline__ float siluf_(float x) { return x * __builtin_amdgcn_rcpf(1.0f + __builtin_amdgcn_exp2f(x * -1.44269504f)); }
__device__ __forceinline__ float wave_sum(float v) {
#define WS_DPP(ctrl, rmask) v += __int_as_float(__builtin_amdgcn_update_dpp(0, __float_as_int(v), ctrl, rmask, 0xf, false))
    v += __int_as_float(__builtin_amdgcn_update_dpp(0, __float_as_int(v), 0x111, 0xf, 0xf, true));
    v += __int_as_float(__builtin_amdgcn_update_dpp(0, __float_as_int(v), 0x112, 0xf, 0xf, true));
    v += __int_as_float(__builtin_amdgcn_update_dpp(0, __float_as_int(v), 0x114, 0xf, 0xf, true));
    v += __int_as_float(__builtin_amdgcn_update_dpp(0, __float_as_int(v), 0x118, 0xf, 0xf, true));
    WS_DPP(0x142, 0xa);
    WS_DPP(0x143, 0xc);
#undef WS_DPP
    return __int_as_float(__builtin_amdgcn_readlane(__float_as_int(v), 63));
}
typedef unsigned u32x2_t __attribute__((ext_vector_type(2)));
__device__ __forceinline__ float rows4_max(float v) {
    u32x2_t r = __builtin_amdgcn_permlane16_swap(__float_as_uint(v), __float_as_uint(v), false, false); v = fmaxf(__uint_as_float(r[0]), __uint_as_float(r[1]));
    r = __builtin_amdgcn_permlane32_swap(__float_as_uint(v), __float_as_uint(v), false, false); return fmaxf(__uint_as_float(r[0]), __uint_as_float(r[1]));
}
__device__ __forceinline__ float rows4_sum(float v) {
    u32x2_t r = __builtin_amdgcn_permlane16_swap(__float_as_uint(v), __float_as_uint(v), false, false); v = __uint_as_float(r[0]) + __uint_as_float(r[1]);
    r = __builtin_amdgcn_permlane32_swap(__float_as_uint(v), __float_as_uint(v), false, false); return __uint_as_float(r[0]) + __uint_as_float(r[1]);
}
__device__ __forceinline__ int opaque_tid() { int t = threadIdx.x; asm volatile("" : "+v"(t)); return t; }
#define TR_READ_ASM(dst, addr, OFF) asm volatile("ds_read_b64_tr_b16 %0, %1 offset:%2" : "=v"(dst) : "v"(addr), "i"(OFF) : "memory")
__device__ __forceinline__ int swz_off(int row, int piece) { return row * 128 + ((piece ^ (row & 7)) << 4); }

constexpr int BM = 128, BN = 256, BK = 64;
constexpr int A_TILE_BYTES = BM * BK * 2, B_TILE_BYTES = BN * BK * 2, STAGE_BYTES = A_TILE_BYTES + B_TILE_BYTES;

template <bool A_LDS>
__device__ __forceinline__ void gemm_compute(f32x4 (&acc)[4][4], const unsigned char* As, const unsigned char* Bs, int wm, int wn, int fr, int fq) {
#pragma unroll
    for (int ks = 0; ks < 2; ++ks) {
        bf16x8 af[4], bfr[4];
#pragma unroll
        for (int mi = 0; mi < 4; ++mi) af[mi] = *(const bf16x8*)(As + swz_off(wm * 64 + mi * 16 + fr, ks * 4 + fq));
#pragma unroll
        for (int ni = 0; ni < 4; ++ni) bfr[ni] = *(const bf16x8*)(Bs + swz_off(wn * 64 + ni * 16 + fr, ks * 4 + fq));
#pragma unroll
        for (int mi = 0; mi < 4; ++mi)
#pragma unroll
            for (int ni = 0; ni < 4; ++ni) acc[mi][ni] = __builtin_amdgcn_mfma_f32_16x16x32_bf16(bfr[ni], af[mi], acc[mi][ni], 0, 0, 0);
    }
}

template <int NBUF, bool A_LDS, class AL, class BL>
__device__ __forceinline__ void gemm_loop(f32x4 (&acc)[4][4], const AL& al, const BL& bl, int nk, unsigned char* smem, const unsigned char* a_lds) {
    const int tid = opaque_tid(), lane = tid & 63, wid = tid >> 6;
    const int wm = wid & 1, wn = wid >> 1, fr = lane & 15, fq = lane >> 4;
    const int lr = tid >> 3, lc = tid & 7;
    constexpr int SB = A_LDS ? B_TILE_BYTES : STAGE_BYTES;
    constexpr int BOFF = A_LDS ? 0 : A_TILE_BYTES;
    uint4 ra[2], rb[4];
    if (!A_LDS) {
#pragma unroll
        for (int i = 0; i < 2; ++i) ra[i] = al(lr + 64 * i, 0, lc);
    }
#pragma unroll
    for (int i = 0; i < 4; ++i) rb[i] = bl(lr + 64 * i, 0, lc);
    if (NBUF == 2) {
        {
            unsigned char* st = smem;
            if (!A_LDS) {
#pragma unroll
                for (int i = 0; i < 2; ++i) *(uint4*)(st + swz_off(lr + 64 * i, lc)) = ra[i];
            }
#pragma unroll
            for (int i = 0; i < 4; ++i) *(uint4*)(st + BOFF + swz_off(lr + 64 * i, lc)) = rb[i];
        }
        __syncthreads();
        for (int kt = 0; kt < nk; ++kt) {
            unsigned char* cur = smem + (kt & 1) * SB;
            unsigned char* nxt = smem + ((kt + 1) & 1) * SB;
            const bool more = (kt + 1 < nk);
            if (more) {
                if (!A_LDS) {
#pragma unroll
                    for (int i = 0; i < 2; ++i) ra[i] = al(lr + 64 * i, kt + 1, lc);
                }
#pragma unroll
                for (int i = 0; i < 4; ++i) rb[i] = bl(lr + 64 * i, kt + 1, lc);
            }
            gemm_compute<A_LDS>(acc, A_LDS ? (a_lds + kt * A_TILE_BYTES) : cur, cur + BOFF, wm, wn, fr, fq);
            if (more) {
                if (!A_LDS) {
#pragma unroll
                    for (int i = 0; i < 2; ++i) *(uint4*)(nxt + swz_off(lr + 64 * i, lc)) = ra[i];
                }
#pragma unroll
                for (int i = 0; i < 4; ++i) *(uint4*)(nxt + BOFF + swz_off(lr + 64 * i, lc)) = rb[i];
            }
            __syncthreads();
        }
    } else {
        for (int kt = 0; kt < nk; ++kt) {
            if (kt > 0) __syncthreads();
            if (!A_LDS) {
#pragma unroll
                for (int i = 0; i < 2; ++i) *(uint4*)(smem + swz_off(lr + 64 * i, lc)) = ra[i];
            }
#pragma unroll
            for (int i = 0; i < 4; ++i) *(uint4*)(smem + BOFF + swz_off(lr + 64 * i, lc)) = rb[i];
            __syncthreads();
            if (kt + 1 < nk) {
                if (!A_LDS) {
#pragma unroll
                    for (int i = 0; i < 2; ++i) ra[i] = al(lr + 64 * i, kt + 1, lc);
                }
#pragma unroll
                for (int i = 0; i < 4; ++i) rb[i] = bl(lr + 64 * i, kt + 1, lc);
            }
            gemm_compute<A_LDS>(acc, A_LDS ? (a_lds + kt * A_TILE_BYTES) : smem, smem + BOFF, wm, wn, fr, fq);
        }
        __syncthreads();
    }
}

struct PlainLoader {
    const u16* base; size_t ld;
    __device__ __forceinline__ uint4 operator()(int r, int kt, int piece) const { return *(const uint4*)(base + (size_t)r * ld + kt * 64 + piece * 8); }
};
struct GatherLoader {
    const u16* base; size_t ld; const int* rows;
    __device__ __forceinline__ uint4 operator()(int r, int kt, int piece) const { return *(const uint4*)(base + (size_t)rows[r] * ld + kt * 64 + piece * 8); }
};
__device__ __forceinline__ void zero_acc(f32x4 (&acc)[4][4]) {
#pragma unroll
    for (int a = 0; a < 4; ++a)
#pragma unroll
        for (int b = 0; b < 4; ++b) acc[a][b] = (f32x4){0.f, 0.f, 0.f, 0.f};
}

__device__ __forceinline__ bf16x8 tr_frag2(const unsigned char* lbase, int off0, int off1) {
    const bf16x4 a = __builtin_amdgcn_ds_read_tr16_b64_v4i16((LAS bf16x4*)(lbase + off0));
    const bf16x4 b = __builtin_amdgcn_ds_read_tr16_b64_v4i16((LAS bf16x4*)(lbase + off1));
    return (bf16x8){a[0], a[1], a[2], a[3], b[0], b[1], b[2], b[3]};
}
__device__ __forceinline__ const unsigned char* tr_lane_base(const unsigned char* tile, int pitch, int row_of_group, int lane) {
    const int i = lane & 15;
    return tile + (row_of_group + (i >> 2)) * pitch + (i & 3) * 8;
}

constexpr int WB_PITCH = 544, WB_TILE_BYTES = 64 * WB_PITCH;

template <bool A_LDS>
__device__ __forceinline__ void gemm_compute_w(f32x4 (&acc)[4][4], const unsigned char* As, const unsigned char* Bs, int wm, int wn, int fr, int fq, int lane) {
    const int i = lane & 15;
    const unsigned char* bb = Bs + (8 * fq + (i >> 2)) * WB_PITCH + ((wn ^ (fq & 1)) * 128) + (i & 3) * 8;
#pragma unroll
    for (int ks = 0; ks < 2; ++ks) {
        bf16x8 af[4], bfr[4];
#pragma unroll
        for (int mi = 0; mi < 4; ++mi) af[mi] = *(const bf16x8*)(As + swz_off(wm * 64 + mi * 16 + fr, ks * 4 + fq));
#pragma unroll
        for (int ni = 0; ni < 4; ++ni) bfr[ni] = tr_frag2(bb, ks * 32 * WB_PITCH + ni * 32, (ks * 32 + 4) * WB_PITCH + ni * 32);
#pragma unroll
        for (int mi = 0; mi < 4; ++mi)
#pragma unroll
            for (int ni = 0; ni < 4; ++ni) acc[mi][ni] = __builtin_amdgcn_mfma_f32_16x16x32_bf16(bfr[ni], af[mi], acc[mi][ni], 0, 0, 0);
    }
}

struct WLoader { const float* base; int ld; __device__ __forceinline__ float4 operator()(int k) const { return *(const float4*)(base + (size_t)k * ld); } };
template <int NBUF, bool A_LDS, class AL, class WL>
__device__ __forceinline__ void gemm_loop_w(f32x4 (&acc)[4][4], const AL& al, const WL& wl, int nk, unsigned char* smem, const unsigned char* a_lds) {
    const int tid = opaque_tid(), lane = tid & 63, wid = tid >> 6;
    const int wm = wid & 1, wn = wid >> 1, fr = lane & 15, fq = lane >> 4;
    const int lr = tid >> 3, lc = tid & 7;
    const int n4 = tid & 63, kr = tid >> 6;
    constexpr int SB = A_LDS ? WB_TILE_BYTES : (A_TILE_BYTES + WB_TILE_BYTES);
    constexpr int BOFF = A_LDS ? 0 : A_TILE_BYTES;
    uint4 ra[2]; float4 rw[8];
    auto load = [&](int kt) {
        if constexpr (!A_LDS) {
#pragma unroll
            for (int i = 0; i < 2; ++i) ra[i] = al(lr + 64 * i, kt, lc);
        }
#pragma unroll
        for (int i = 0; i < 8; ++i) rw[i] = wl(kt * 64 + kr + 8 * i);
    };
    auto store = [&](unsigned char* st) {
        if constexpr (!A_LDS) {
#pragma unroll
            for (int i = 0; i < 2; ++i) *(uint4*)(st + swz_off(lr + 64 * i, lc)) = ra[i];
        }
#pragma unroll
        for (int i = 0; i < 8; ++i) {
            const int k = kr + 8 * i;
            uint2 w; w.x = pk2(rw[i].x, rw[i].y); w.y = pk2(rw[i].z, rw[i].w);
            *(uint2*)(st + BOFF + k * WB_PITCH + ((n4 * 8) ^ ((i & 1) << 7))) = w;
        }
    };
    load(0);
    if (NBUF == 2) {
        store(smem);
        __syncthreads();
        for (int kt = 0; kt < nk; ++kt) {
            unsigned char* cur = smem + (kt & 1) * SB;
            unsigned char* nxt = smem + ((kt + 1) & 1) * SB;
            const bool more = (kt + 1 < nk);
            if (more) load(kt + 1);
            gemm_compute_w<A_LDS>(acc, A_LDS ? (a_lds + kt * A_TILE_BYTES) : cur, cur + BOFF, wm, wn, fr, fq, lane);
            if (more) store(nxt);
            __syncthreads();
        }
    } else {
        for (int kt = 0; kt < nk; ++kt) {
            if (kt > 0) __syncthreads();
            store(smem);
            __syncthreads();
            if (kt + 1 < nk) load(kt + 1);
            gemm_compute_w<A_LDS>(acc, A_LDS ? (a_lds + kt * A_TILE_BYTES) : smem, smem + BOFF, wm, wn, fr, fq, lane);
        }
        __syncthreads();
    }
}


namespace pg8 {
#define PG8_LAS __attribute__((address_space(3)))
typedef unsigned short bf16_t;
typedef short bf16x8 __attribute__((ext_vector_type(8)));
typedef float f32x4 __attribute__((ext_vector_type(4)));
typedef unsigned u32x4 __attribute__((ext_vector_type(4)));
constexpr int BM = 256, BK = 64, HALF = 128, HTB = HALF * BK * 2  , STAGE_BYTES = 8 * HTB, NXCD = 8, WGM = 8;

__host__ __device__ __forceinline__ int lds_byte(int r, int c) { const int st = (r >> 4) * 2 + (c >> 5), rr = r & 15, cc = c & 31, ob = rr * 64 + cc * 2; return st * 1024 + (ob ^ (((ob >> 9) & 1) << 5)); }
__host__ __device__ __forceinline__ void stage_rc(int b, int& R, int& C) { const int st = b / 1024, sb = b % 1024, swz = sb ^ (((sb >> 9) & 1) << 5); R = (st >> 1) * 16 + swz / 64; C = (st & 1) * 32 + (swz % 64) / 2; }
__host__ __device__ __forceinline__ int perm32(int rho) { const int n = rho >> 4, i = rho & 15; return 8 * (i >> 2) + 4 * n + (i & 3); }

struct Unit { int pm, pn; };
struct Gemm { const bf16_t* A; const bf16_t* Bt; int M, N, K; };

struct StaticOrder {
    int nM, nN, nwg, G, c;
    __host__ __device__ void init(int M, int N, int G_, int c_) { nM = M / BM; nN = N / BM; nwg = nM * nN; G = G_; c = c_; }
    __host__ __device__ bool next(int i, Unit& u) const {
        const long L = (long)i * G + c; if (L >= nwg) return false;
        int wgid = (int)L; { const int q = nwg / NXCD, r = nwg % NXCD, xcd = wgid % NXCD, off = wgid / NXCD; wgid = (xcd < r ? xcd * (q + 1) : r * (q + 1) + (xcd - r) * q) + off; }
        const int nig = WGM * nN, gid = wgid / nig, fm = gid * WGM, gsz = (nM - fm) < WGM ? (nM - fm) : WGM;
        u.pm = fm + ((wgid % nig) % gsz); u.pn = (wgid % nig) / gsz; return true;
    }
    __device__ __forceinline__ void a_ready(const Unit&) const {}
    __device__ __forceinline__ void done(const Unit&) const {}
};

__device__ __forceinline__ unsigned cvt_pk_bf16(float lo, float hi) { unsigned r; asm volatile("v_cvt_pk_bf16_f32 %0, %1, %2" : "=v"(r) : "v"(lo), "v"(hi)); return r; }
template <class Epi, class Sched, bool ALIGN_EPI = false, bool SP2 = false>
__device__ __forceinline__ void gemm_phase(PG8_LAS unsigned char* lds, const Gemm g, const Sched& S, const Epi& E) {
    const int tid = opaque_tid(), wid = __builtin_amdgcn_readfirstlane(tid >> 6), lane = tid & 63, wr = wid >> 2, wc = wid & 3, fr = lane & 15, fq = lane >> 4;
    const int K = g.K, nt = K / BK;
    unsigned voffA[2], voffB[2];
#pragma unroll
    for (int i = 0; i < 2; ++i) { int R, C; stage_rc(tid * 16 + i * 8192, R, C); const int Rb = Epi::PERM ? ((R & ~31) + perm32(R & 31)) : R;
        voffA[i] = (unsigned)(R * K + C) * 2u; voffB[i] = (unsigned)(Rb * K + C) * 2u; }
    const size_t kstep = (size_t)(BK * 2);
    const size_t hstep = (size_t)HALF * K * 2;
    const size_t tstep = 2 * hstep;
    const unsigned ldsw = (unsigned)wid * 1024u;
    const int aoff = lds_byte(wr * 64 + fr, fq * 8), boff = lds_byte(wc * 32 + fr, fq * 8);
#define PG8_SA(b, h) (((b) * 2 + (h)) * HTB)
#define PG8_SB(b, h) ((4 + (b) * 2 + (h)) * HTB)
#define PG8_STAGE(bufoff, gbase, voff) do { _Pragma("unroll") for (int _i = 0; _i < 2; ++_i) \
        __builtin_amdgcn_global_load_lds((const unsigned*)((const char*)(gbase) + (voff)[_i]), (PG8_LAS unsigned*)(lds + (bufoff) + ldsw + _i * 8192), 16, 0, 0); } while (0)
#define PG8_LDA(dst, b, h) do { _Pragma("unroll") for (int m = 0; m < 4; ++m) _Pragma("unroll") for (int k = 0; k < 2; ++k) dst[m][k] = *(const PG8_LAS bf16x8*)(lds + PG8_SA(b, h) + aoff + m * 2048 + k * 1024); } while (0)
#define PG8_LDB(dst, b, h) do { _Pragma("unroll") for (int n = 0; n < 2; ++n) _Pragma("unroll") for (int k = 0; k < 2; ++k) dst[n][k] = *(const PG8_LAS bf16x8*)(lds + PG8_SB(b, h) + boff + n * 2048 + k * 1024); } while (0)
#define PG8_MMA(ai, bj, At, Bt) do { __builtin_amdgcn_s_setprio(1); _Pragma("unroll") for (int m = 0; m < 4; ++m) _Pragma("unroll") for (int n = 0; n < 2; ++n) _Pragma("unroll") for (int k = 0; k < 2; ++k) \
        acc[ai][bj][m][n] = __builtin_amdgcn_mfma_f32_16x16x32_bf16(Bt[n][k], At[m][k], acc[ai][bj][m][n], 0, 0, 0); __builtin_amdgcn_s_setprio(0); } while (0)
#define PG8_WAIT_V(n) asm volatile("s_waitcnt vmcnt(" #n ")" ::: "memory")
#define PG8_WAIT_L(n) asm volatile("s_waitcnt lgkmcnt(" #n ")" ::: "memory")
#define PG8_BAR __builtin_amdgcn_s_barrier()
#define PG8_SCHED __builtin_amdgcn_sched_barrier(0)
    Unit cur, nxt; int ui = 0;
    if (!S.next(0, cur)) return;
    f32x4 acc[2][2][4][2];
#pragma unroll
    for (int a = 0; a < 2; ++a)
#pragma unroll
        for (int b = 0; b < 2; ++b)
#pragma unroll
            for (int m = 0; m < 4; ++m)
#pragma unroll
                for (int n = 0; n < 2; ++n) acc[a][b][m][n] = (f32x4){0.f, 0.f, 0.f, 0.f};
    bf16x8 At[4][2], B0[2][2], B1[2][2];
    const char* cA = (const char*)g.A + (size_t)cur.pm * tstep; const char* cB = (const char*)g.Bt + (size_t)cur.pn * tstep;
    S.a_ready(cur);
    if constexpr (SP2) {
        PG8_STAGE(PG8_SB(0, 0), cB, voffB); PG8_STAGE(PG8_SB(0, 1), cB + hstep, voffB); PG8_STAGE(PG8_SA(0, 0), cA, voffA); PG8_STAGE(PG8_SA(0, 1), cA + hstep, voffA);
        if (wr == 1) PG8_BAR;
        PG8_WAIT_V(2); PG8_BAR;
        PG8_STAGE(PG8_SB(1, 0), cB + kstep, voffB); PG8_STAGE(PG8_SA(1, 0), cA + kstep, voffA); PG8_STAGE(PG8_SB(1, 1), cB + hstep + kstep, voffB);
        PG8_WAIT_V(6); PG8_BAR;
    } else {
        PG8_STAGE(PG8_SB(0, 0), cB, voffB); PG8_STAGE(PG8_SA(0, 0), cA, voffA); PG8_STAGE(PG8_SB(0, 1), cB + hstep, voffB); PG8_STAGE(PG8_SA(0, 1), cA + hstep, voffA);
        if (wr == 1) PG8_BAR;
        PG8_WAIT_V(4); PG8_BAR;
        PG8_STAGE(PG8_SB(1, 0), cB + kstep, voffB); PG8_STAGE(PG8_SA(1, 0), cA + kstep, voffA); PG8_STAGE(PG8_SB(1, 1), cB + hstep + kstep, voffB);
        PG8_WAIT_V(6); PG8_BAR;
    }
    for (;;) {
        const bool has_next = S.next(ui + 1, nxt);
        const char* nA = has_next ? (const char*)g.A + (size_t)nxt.pm * tstep : cA; const char* nB = has_next ? (const char*)g.Bt + (size_t)nxt.pn * tstep : cB;
        for (int t = 0; t < nt; t += 2) {
            const bool last = (t == nt - 2);
            const char* a1 = cA + (size_t)(t + 1) * kstep;
            const char* a2 = last ? nA : cA + (size_t)(t + 2) * kstep; const char* b2 = last ? nB : cB + (size_t)(t + 2) * kstep;
            const char* a3 = a2 + kstep; const char* b3 = b2 + kstep;
            if (last && has_next) S.a_ready(nxt);
            if constexpr (SP2) {
            PG8_LDB(B0, 0, 0); PG8_LDB(B1, 0, 1); PG8_SCHED; PG8_LDA(At, 0, 0); PG8_STAGE(PG8_SA(1, 1), a1 + hstep, voffA);
            PG8_WAIT_V(8); PG8_WAIT_L(0); PG8_BAR; PG8_MMA(0, 0, At, B0); PG8_MMA(0, 1, At, B1); PG8_BAR; PG8_SCHED;
            PG8_LDA(At, 0, 1); PG8_STAGE(PG8_SB(0, 0), b2, voffB); PG8_STAGE(PG8_SB(0, 1), b2 + hstep, voffB); PG8_STAGE(PG8_SA(0, 0), a2, voffA);
            PG8_WAIT_V(8); PG8_WAIT_L(0); PG8_BAR; PG8_MMA(1, 0, At, B0); PG8_MMA(1, 1, At, B1); PG8_BAR; PG8_SCHED;
            PG8_LDB(B0, 1, 0); PG8_LDB(B1, 1, 1); PG8_SCHED; PG8_LDA(At, 1, 0); PG8_STAGE(PG8_SA(0, 1), a2 + hstep, voffA);
            PG8_WAIT_V(8); PG8_WAIT_L(0); PG8_BAR; PG8_MMA(0, 0, At, B0); PG8_MMA(0, 1, At, B1); PG8_BAR; PG8_SCHED;
            PG8_LDA(At, 1, 1); PG8_STAGE(PG8_SB(1, 0), b3, voffB); PG8_STAGE(PG8_SB(1, 1), b3 + hstep, voffB); PG8_STAGE(PG8_SA(1, 0), a3, voffA);
            PG8_WAIT_V(8); PG8_WAIT_L(0); PG8_BAR; PG8_MMA(1, 0, At, B0); PG8_MMA(1, 1, At, B1); PG8_BAR; PG8_SCHED;
            } else {
            PG8_LDB(B0, 0, 0); PG8_SCHED; PG8_LDA(At, 0, 0); PG8_STAGE(PG8_SA(1, 1), a1 + hstep, voffA);
            PG8_WAIT_L(8); PG8_BAR; PG8_WAIT_L(0); PG8_MMA(0, 0, At, B0); PG8_BAR; PG8_SCHED;
            PG8_LDB(B1, 0, 1); PG8_STAGE(PG8_SB(0, 0), b2, voffB);
            PG8_BAR; PG8_WAIT_L(0); PG8_MMA(0, 1, At, B1); PG8_BAR;
            PG8_LDA(At, 0, 1); PG8_STAGE(PG8_SA(0, 0), a2, voffA);
            PG8_BAR; PG8_WAIT_L(0); PG8_MMA(1, 0, At, B0); PG8_BAR; PG8_SCHED;
            PG8_STAGE(PG8_SB(0, 1), b2 + hstep, voffB);
            PG8_WAIT_V(6); PG8_BAR; PG8_MMA(1, 1, At, B1); PG8_BAR;
            PG8_LDB(B0, 1, 0); PG8_SCHED; PG8_LDA(At, 1, 0); PG8_STAGE(PG8_SA(0, 1), a2 + hstep, voffA);
            PG8_WAIT_L(8); PG8_BAR; PG8_WAIT_L(0); PG8_MMA(0, 0, At, B0); PG8_BAR; PG8_SCHED;
            PG8_LDB(B1, 1, 1); PG8_STAGE(PG8_SB(1, 0), b3, voffB);
            PG8_BAR; PG8_WAIT_L(0); PG8_MMA(0, 1, At, B1); PG8_BAR;
            PG8_LDA(At, 1, 1); PG8_STAGE(PG8_SA(1, 0), a3, voffA);
            PG8_BAR; PG8_WAIT_L(0); PG8_MMA(1, 0, At, B0); PG8_BAR; PG8_SCHED;
            PG8_STAGE(PG8_SB(1, 1), b3 + hstep, voffB);
            PG8_WAIT_V(6); PG8_BAR; PG8_MMA(1, 1, At, B1); PG8_BAR;
            }
        }
        if constexpr (ALIGN_EPI) { if (wr == 0) PG8_BAR; }
        if constexpr (!Epi::AFTER_DRAIN) { E(acc, cur, wr, wc, fr, fq); S.done(cur); }
        if (!has_next) break;
#pragma unroll
        for (int a = 0; a < 2; ++a)
#pragma unroll
            for (int b = 0; b < 2; ++b)
#pragma unroll
                for (int m = 0; m < 4; ++m)
#pragma unroll
                    for (int n = 0; n < 2; ++n) acc[a][b][m][n] = (f32x4){0.f, 0.f, 0.f, 0.f};
        cur = nxt; cA = nA; cB = nB; ++ui;
        if constexpr (ALIGN_EPI) { if (wr == 1) PG8_BAR; }
    }
    PG8_WAIT_V(0);
    if constexpr (!ALIGN_EPI) { if (wr == 0) PG8_BAR; }
    PG8_BAR;
    if constexpr (Epi::AFTER_DRAIN) { E.fused(acc, cur, wr, wc, fr, fq, lds, wid, lane); S.done(cur); }
#undef PG8_SA
#undef PG8_SB
#undef PG8_STAGE
#undef PG8_LDA
#undef PG8_LDB
#undef PG8_MMA
#undef PG8_WAIT_V
#undef PG8_WAIT_L
#undef PG8_BAR
#undef PG8_SCHED
}
}

struct EpiProj {
    static constexpr bool PERM = true, AFTER_DRAIN = false;
    u16* O;
    __device__ __forceinline__ void operator()(const pg8::f32x4 (&acc)[2][2][4][2], const pg8::Unit& u, int wr, int wc, int fr, int fq) const {
        const int c0 = u.pn * 256;
        const int mode = (c0 >= C_GA) ? 3 : (c0 >= C_GR) ? 2 : (c0 >= C_KR && c0 < C_VR) ? 1 : 0;
        const int row0 = u.pm * 256 + wr * 64 + fr, col0 = c0 + wc * 32 + 8 * fq;
#pragma unroll
        for (int ai = 0; ai < 2; ++ai)
#pragma unroll
            for (int m = 0; m < 4; ++m) {
                u16* rowp = O + (size_t)(row0 + ai * 128 + m * 16) * NPROJ + col0;
#pragma unroll
                for (int bj = 0; bj < 2; ++bj) {
                    float v[8];
#pragma unroll
                    for (int j = 0; j < 4; ++j) { v[j] = acc[ai][bj][m][0][j]; v[4 + j] = acc[ai][bj][m][1][j]; }
#pragma unroll
                    for (int j = 0; j < 8; ++j) { if (mode == 1) v[j] *= 0.125f; else if (mode == 2) v[j] = siluf_(v[j]); else if (mode == 3) v[j] = sigmoidf_(v[j]); }
                    uint4 w; w.x = pk2(v[0], v[1]); w.y = pk2(v[2], v[3]); w.z = pk2(v[4], v[5]); w.w = pk2(v[6], v[7]);
                    *(uint4*)(rowp + bj * 128) = w;
                }
                asm volatile("" ::: "memory");
            }
    }
};
#define EPI_GLOAD16(dst, ptr) asm volatile("global_load_dwordx4 %0, %1, off" : "=v"(dst) : "v"(ptr) : "memory")
template <int STEP  > struct EpiMerge {
    static constexpr bool PERM = true, AFTER_DRAIN = false;
    u16* MG; const u16* PROJ;
    __device__ __forceinline__ void operator()(const pg8::f32x4 (&acc)[2][2][4][2], const pg8::Unit& u, int wr, int wc, int fr, int fq) const {
        const int row0 = u.pm * 256 + wr * 64 + fr, col0 = u.pn * 256 + wc * 32 + 8 * fq;
        const u16* gbase = PROJ + (size_t)row0 * NPROJ + (STEP == 0 ? C_GA : C_GT) + col0;
        u16* mbase = MG + (size_t)row0 * 1024 + col0;
        pg8::u32x4 gq[2][2], tq[2][2];
#define EPM_LOAD(it_) do { const size_t ro_ = (size_t)(((it_) >> 2) * 128 + ((it_) & 3) * 16); \
            EPI_GLOAD16(gq[(it_) & 1][0], gbase + ro_ * NPROJ); EPI_GLOAD16(gq[(it_) & 1][1], gbase + ro_ * NPROJ + 128); \
            if (STEP == 1) { EPI_GLOAD16(tq[(it_) & 1][0], mbase + ro_ * 1024); EPI_GLOAD16(tq[(it_) & 1][1], mbase + ro_ * 1024 + 128); } } while (0)
#define EPM_WAIT(it_, N0, N1) do { if (STEP == 0) asm volatile("s_waitcnt vmcnt(" #N0 ")" : "+v"(gq[(it_) & 1][0]), "+v"(gq[(it_) & 1][1]) :: "memory"); \
            else asm volatile("s_waitcnt vmcnt(" #N1 ")" : "+v"(gq[(it_) & 1][0]), "+v"(gq[(it_) & 1][1]), "+v"(tq[(it_) & 1][0]), "+v"(tq[(it_) & 1][1]) :: "memory"); } while (0)
#define EPM_BODY(it_) do { const int ai = (it_) >> 2, m = (it_) & 3; const size_t ro_ = (size_t)(ai * 128 + m * 16); \
            _Pragma("unroll") for (int bj = 0; bj < 2; ++bj) { \
                const pg8::u32x4 g = gq[(it_) & 1][bj]; \
                float v[8]; \
                _Pragma("unroll") for (int j = 0; j < 4; ++j) { v[j] = acc[ai][bj][m][0][j]; v[4 + j] = acc[ai][bj][m][1][j]; } \
                _Pragma("unroll") for (int j = 0; j < 4; ++j) { v[2 * j] *= bf2f((u16)(g[j] & 0xffff)); v[2 * j + 1] *= bf2f((u16)(g[j] >> 16)); } \
                if (STEP == 1) { const pg8::u32x4 t = tq[(it_) & 1][bj]; \
                    _Pragma("unroll") for (int j = 0; j < 4; ++j) { v[2 * j] += bf2f((u16)(t[j] & 0xffff)); v[2 * j + 1] += bf2f((u16)(t[j] >> 16)); } } \
                uint4 w; w.x = pk2(v[0], v[1]); w.y = pk2(v[2], v[3]); w.z = pk2(v[4], v[5]); w.w = pk2(v[6], v[7]); \
                *(uint4*)(mbase + ro_ * 1024 + bj * 128) = w; } \
            asm volatile("" ::: "memory"); } while (0)
        EPM_LOAD(0);
        EPM_LOAD(1); EPM_WAIT(0, 2, 4); EPM_BODY(0);
        EPM_LOAD(2); EPM_WAIT(1, 4, 6); EPM_BODY(1);
        EPM_LOAD(3); EPM_WAIT(2, 4, 6); EPM_BODY(2);
        EPM_LOAD(4); EPM_WAIT(3, 4, 6); EPM_BODY(3);
        EPM_LOAD(5); EPM_WAIT(4, 4, 6); EPM_BODY(4);
        EPM_LOAD(6); EPM_WAIT(5, 4, 6); EPM_BODY(5);
        EPM_LOAD(7); EPM_WAIT(6, 4, 6); EPM_BODY(6);
        EPM_WAIT(7, 2, 2); EPM_BODY(7);
#undef EPM_LOAD
#undef EPM_WAIT
#undef EPM_BODY
    }
};
struct EpiOut {
    static constexpr bool PERM = false, AFTER_DRAIN = false;
    const float* x; const float* mod; float* X1;
    __device__ __forceinline__ void operator()(const pg8::f32x4 (&acc)[2][2][4][2], const pg8::Unit& u, int wr, int wc, int fr, int fq) const {
        const int row0 = u.pm * 256 + wr * 64 + fr, col0 = u.pn * 256 + wc * 32 + 4 * fq;
        const float* gt1 = mod + (u.pm * 256 >= SEQ ? 6144 : 0) + 2048;
        const float* xbase = x + (size_t)row0 * D + col0; float* obase = X1 + (size_t)row0 * D + col0;
        float4 gv[2][2];
#pragma unroll
        for (int bj = 0; bj < 2; ++bj)
#pragma unroll
            for (int n = 0; n < 2; ++n) gv[bj][n] = *(const float4*)(gt1 + col0 + bj * 128 + n * 16);
        pg8::f32x4 xq[2][4];
#define EPO_LOAD(it_) do { const size_t ro_ = (size_t)(((it_) >> 2) * 128 + ((it_) & 3) * 16) * D; \
            EPI_GLOAD16(xq[(it_) & 1][0], xbase + ro_); EPI_GLOAD16(xq[(it_) & 1][1], xbase + ro_ + 16); EPI_GLOAD16(xq[(it_) & 1][2], xbase + ro_ + 128); EPI_GLOAD16(xq[(it_) & 1][3], xbase + ro_ + 144); } while (0)
#define EPO_WAIT(it_, N) asm volatile("s_waitcnt vmcnt(" #N ")" : "+v"(xq[(it_) & 1][0]), "+v"(xq[(it_) & 1][1]), "+v"(xq[(it_) & 1][2]), "+v"(xq[(it_) & 1][3]) :: "memory")
#define EPO_BODY(it_) do { const int ai = (it_) >> 2, m = (it_) & 3; const size_t ro_ = (size_t)(ai * 128 + m * 16) * D; \
            _Pragma("unroll") for (int bj = 0; bj < 2; ++bj) \
                _Pragma("unroll") for (int n = 0; n < 2; ++n) { \
                    const pg8::f32x4 xv = xq[(it_) & 1][bj * 2 + n]; const float4 g = gv[bj][n]; \
                    float4 o; o.x = xv[0] + g.x * acc[ai][bj][m][n][0]; o.y = xv[1] + g.y * acc[ai][bj][m][n][1]; o.z = xv[2] + g.z * acc[ai][bj][m][n][2]; o.w = xv[3] + g.w * acc[ai][bj][m][n][3]; \
                    *(float4*)(obase + ro_ + bj * 128 + n * 16) = o; } \
            asm volatile("" ::: "memory"); } while (0)
        EPO_LOAD(0);
        EPO_LOAD(1); EPO_WAIT(0, 4); EPO_BODY(0);
        EPO_LOAD(2); EPO_WAIT(1, 8); EPO_BODY(1);
        EPO_LOAD(3); EPO_WAIT(2, 8); EPO_BODY(2);
        EPO_LOAD(4); EPO_WAIT(3, 8); EPO_BODY(3);
        EPO_LOAD(5); EPO_WAIT(4, 8); EPO_BODY(4);
        EPO_LOAD(6); EPO_WAIT(5, 8); EPO_BODY(5);
        EPO_LOAD(7); EPO_WAIT(6, 8); EPO_BODY(6);
        EPO_WAIT(7, 4); EPO_BODY(7);
#undef EPO_LOAD
#undef EPO_WAIT
#undef EPO_BODY
    }
};
struct EpiLogits {
    static constexpr bool PERM = false, AFTER_DRAIN = false;
    float* LG;
    __device__ __forceinline__ void operator()(const pg8::f32x4 (&acc)[2][2][4][2], const pg8::Unit& u, int wr, int wc, int fr, int fq) const {
        const int row0 = u.pm * 256 + wr * 64 + fr, col0 = wc * 32 + 4 * fq;
#pragma unroll
        for (int ai = 0; ai < 2; ++ai)
#pragma unroll
            for (int m = 0; m < 4; ++m)
#pragma unroll
                for (int bj = 0; bj < 2; ++bj)
#pragma unroll
                    for (int n = 0; n < 2; ++n) *(pg8::f32x4*)(LG + (size_t)(row0 + ai * 128 + m * 16) * 256 + col0 + bj * 128 + n * 16) = acc[ai][bj][m][n];
    }
};

struct EpiRouterShared {
    static constexpr bool PERM = false, AFTER_DRAIN = false;
    float* LG; u16* GSH;
    __device__ __forceinline__ void operator()(const pg8::f32x4 (&acc)[2][2][4][2], const pg8::Unit& u, int wr, int wc, int fr, int fq) const {
        const int row0 = u.pm * 256 + wr * 64 + fr;
        if (u.pn == 0) {
            const int col0 = wc * 32 + 4 * fq;
#pragma unroll
            for (int ai = 0; ai < 2; ++ai)
#pragma unroll
                for (int m = 0; m < 4; ++m)
#pragma unroll
                    for (int bj = 0; bj < 2; ++bj)
#pragma unroll
                        for (int n = 0; n < 2; ++n) *(pg8::f32x4*)(LG + (size_t)(row0 + ai * 128 + m * 16) * 256 + col0 + bj * 128 + n * 16) = acc[ai][bj][m][n];
        } else {
            const int g0 = (u.pn - 1) * 128 + wc * 16 + 4 * fq;
#pragma unroll
            for (int ai = 0; ai < 2; ++ai)
#pragma unroll
                for (int m = 0; m < 4; ++m)
#pragma unroll
                    for (int bj = 0; bj < 2; ++bj) {
                        float g[4];
#pragma unroll
                        for (int j = 0; j < 4; ++j) g[j] = siluf_(acc[ai][bj][m][0][j]) * acc[ai][bj][m][1][j];
                        uint2 w; w.x = pk2(g[0], g[1]); w.y = pk2(g[2], g[3]);
                        *(uint2*)(GSH + (size_t)(row0 + ai * 128 + m * 16) * 256 + g0 + bj * 64) = w;
                    }
        }
    }
};
struct EpiSharedOut {
    static constexpr bool PERM = true, AFTER_DRAIN = false;
    u16* OS;
    __device__ __forceinline__ void operator()(const pg8::f32x4 (&acc)[2][2][4][2], const pg8::Unit& u, int wr, int wc, int fr, int fq) const {
        const int row0 = u.pm * 256 + wr * 64 + fr, col0 = u.pn * 256 + wc * 32 + 8 * fq;
#pragma unroll
        for (int ai = 0; ai < 2; ++ai)
#pragma unroll
            for (int m = 0; m < 4; ++m) {
                u16* rowp = OS + ((size_t)T * 8 + row0 + ai * 128 + m * 16) * 1024 + col0;
#pragma unroll
                for (int bj = 0; bj < 2; ++bj) {
                    uint4 w; w.x = pk2(acc[ai][bj][m][0][0], acc[ai][bj][m][0][1]); w.y = pk2(acc[ai][bj][m][0][2], acc[ai][bj][m][0][3]);
                    w.z = pk2(acc[ai][bj][m][1][0], acc[ai][bj][m][1][1]); w.w = pk2(acc[ai][bj][m][1][2], acc[ai][bj][m][1][3]);
                    *(uint4*)(rowp + bj * 128) = w;
                }
            }
    }
};

template <int MODE  >
__device__ __forceinline__ int dst_row(int n) { return MODE == 0 ? n : ((n >> 4) * 32 + (n & 15) + (MODE == 2 ? 16 : 0)); }

template <int MODE>
__device__ __forceinline__ void transpose_unit(const float* src, int N, int K, u16* dst, int k0, int n0, unsigned char* smem) {
    u16* tl = (u16*)smem;
    const int tid = opaque_tid();
    {
        const int kr = tid >> 4, nc = tid & 15;
        float4 v[2][4];
#pragma unroll
        for (int pss = 0; pss < 2; ++pss)
#pragma unroll
            for (int q = 0; q < 4; ++q) v[pss][q] = *(const float4*)(src + (size_t)(k0 + kr + 32 * pss) * N + n0 + q * 64 + nc * 4);
#pragma unroll
        for (int pss = 0; pss < 2; ++pss)
#pragma unroll
            for (int q = 0; q < 4; ++q) {
                const int k = kr + 32 * pss; u16* t = tl + q * 64 * 72;
                t[(nc * 4 + 0) * 72 + k] = f2bf(v[pss][q].x); t[(nc * 4 + 1) * 72 + k] = f2bf(v[pss][q].y);
                t[(nc * 4 + 2) * 72 + k] = f2bf(v[pss][q].z); t[(nc * 4 + 3) * 72 + k] = f2bf(v[pss][q].w);
            }
    }
    __syncthreads();
    {
        const int n = tid >> 3, kc = tid & 7;
#pragma unroll
        for (int q = 0; q < 4; ++q) {
            const uint4 v = *(const uint4*)(tl + (q * 64 + n) * 72 + kc * 8);
            *(uint4*)(dst + (size_t)dst_row<MODE>(n0 + q * 64 + n) * K + k0 + kc * 8) = v;
        }
    }
    __syncthreads();
}

__device__ __forceinline__ void transpose_all(const Params& p, unsigned char* smem, int bid, int nb) {
    unsigned char* ws = p.ws;
    constexpr int U_IN = 16 * (NPROJ / 256), U_PA = 8 * 4, U_PR = 16 * 4, U_OUT = 16 * 4, U_RT = 16, U_S1 = 16, U_S3 = 16, U_S2 = 4 * 4;
    constexpr int U_TOT = U_IN + U_PA + U_PR + U_OUT + U_RT + U_S1 + U_S3 + U_S2;
    for (int u = nb - 1 - bid; u < U_TOT; u += nb) {
        int r = u;
        if (r < U_IN) { transpose_unit<0>(p.w_in, NPROJ, 1024, (u16*)(ws + WS_WTIN), (r % 16) * 64, (r / 16) * 256, smem); continue; } r -= U_IN;
        if (r < U_PA) { transpose_unit<0>(p.w_pa, 1024, 512, (u16*)(ws + WS_WTPA), (r % 8) * 64, (r / 8) * 256, smem); continue; } r -= U_PA;
        if (r < U_PR) { transpose_unit<0>(p.w_pr, 1024, 1024, (u16*)(ws + WS_WTPR), (r % 16) * 64, (r / 16) * 256, smem); continue; } r -= U_PR;
        if (r < U_OUT) { transpose_unit<0>(p.w_out, 1024, 1024, (u16*)(ws + WS_WTOUT), (r % 16) * 64, (r / 16) * 256, smem); continue; } r -= U_OUT;
        if (r < U_RT) { transpose_unit<0>(p.w_router, 256, 1024, (u16*)(ws + WS_WTRT), (r % 16) * 64, 0, smem); continue; } r -= U_RT;
        if (r < U_S1) { transpose_unit<1>(p.ws1, 256, 1024, (u16*)(ws + WS_WTS13), (r % 16) * 64, 0, smem); continue; } r -= U_S1;
        if (r < U_S3) { transpose_unit<2>(p.ws3, 256, 1024, (u16*)(ws + WS_WTS13), (r % 16) * 64, 0, smem); continue; } r -= U_S3;
        transpose_unit<0>(p.ws2, 1024, 256, (u16*)(ws + WS_WTS2), (r % 4) * 64, (r / 4) * 256, smem);
    }
}

__device__ __forceinline__ void phase_prologue(const Params& p, unsigned char* smem, int bid, int nb) {
    const int tid = opaque_tid();
    unsigned char* ws = p.ws;
    for (int item = bid; item < 192; item += nb) {
        float* red = (float*)smem;
        const int cg = tid & 7, rg = tid >> 3;
        const int col = item * 32 + cg * 4;
        float a0[4] = {0, 0, 0, 0}, a1[4] = {0, 0, 0, 0};
#pragma unroll
        for (int i = 0; i < 16; ++i) {
            const int r = rg * 16 + i;
            const float4 w = *(const float4*)(p.w_ada + (size_t)r * 6144 + col);
            const float c0 = p.c[r], c1 = p.c[1024 + r];
            const float s0 = siluf_(c0), s1 = siluf_(c1);
            a0[0] += s0 * w.x; a0[1] += s0 * w.y; a0[2] += s0 * w.z; a0[3] += s0 * w.w;
            a1[0] += s1 * w.x; a1[1] += s1 * w.y; a1[2] += s1 * w.z; a1[3] += s1 * w.w;
        }
#pragma unroll
        for (int j = 0; j < 4; ++j) { red[(rg * 2 + 0) * 32 + cg * 4 + j] = a0[j]; red[(rg * 2 + 1) * 32 + cg * 4 + j] = a1[j]; }
        __syncthreads();
        if (tid < 64) {
            const int b = tid >> 5, cc = tid & 31;
            float s = 0.f;
            for (int r = 0; r < 64; ++r) s += red[(r * 2 + b) * 32 + cc];
            ((float*)(ws + WS_MOD))[b * 6144 + item * 32 + cc] = s + p.b_ada[item * 32 + cc];
        }
        __syncthreads();
    }
    transpose_all(p, smem, bid, nb);
}

__device__ __forceinline__ void phase_norm_mod(const float* xin, const float* g, const float* mod, int sh_off, int sc_off, u16* hout, int bid, int nb) {
    const int tid_ = opaque_tid(); const int lane = tid_ & 63, gw = bid * (NT / 64) + (tid_ >> 6), nw = nb * (NT / 64);
    for (int row = gw; row < T; row += 2 * nw) {
        const int row2 = row + nw; const bool has2 = row2 < T; const int r2 = has2 ? row2 : row;
        const float* xr = xin + (size_t)row * D; const float* xr2 = xin + (size_t)r2 * D;
        float4 v[4], u[4]; float ss = 0.f, ss2 = 0.f;
#pragma unroll
        for (int i = 0; i < 4; ++i) { v[i] = *(const float4*)(xr + ((i >> 1) * 64 + lane) * 8 + (i & 1) * 4); u[i] = *(const float4*)(xr2 + ((i >> 1) * 64 + lane) * 8 + (i & 1) * 4); }
#pragma unroll
        for (int i = 0; i < 4; ++i) { ss += v[i].x * v[i].x + v[i].y * v[i].y + v[i].z * v[i].z + v[i].w * v[i].w; ss2 += u[i].x * u[i].x + u[i].y * u[i].y + u[i].z * u[i].z + u[i].w * u[i].w; }
        ss = wave_sum(ss); ss2 = wave_sum(ss2);
        const float rstd = rsqrtf(ss * (1.0f / D) + 1e-6f), rstd2 = rsqrtf(ss2 * (1.0f / D) + 1e-6f);
        const float* mb = mod + (row >= SEQ ? 6144 : 0); const float* mb2 = mod + (r2 >= SEQ ? 6144 : 0);
#pragma unroll
        for (int i = 0; i < 2; ++i) {
            const int col = (i * 64 + lane) * 8;
            unsigned w[4], w2[4];
#pragma unroll
            for (int h = 0; h < 2; ++h) {
                const float4 gg = *(const float4*)(g + col + h * 4);
                const float4 sc = *(const float4*)(mb + sc_off + col + h * 4), sh = *(const float4*)(mb + sh_off + col + h * 4);
                const float4 sc2 = *(const float4*)(mb2 + sc_off + col + h * 4), sh2 = *(const float4*)(mb2 + sh_off + col + h * 4);
                const float4 x = v[i * 2 + h], y = u[i * 2 + h];
                w[h * 2] = pk2(x.x * rstd * gg.x * (1.f + sc.x) + sh.x, x.y * rstd * gg.y * (1.f + sc.y) + sh.y);
                w[h * 2 + 1] = pk2(x.z * rstd * gg.z * (1.f + sc.z) + sh.z, x.w * rstd * gg.w * (1.f + sc.w) + sh.w);
                w2[h * 2] = pk2(y.x * rstd2 * gg.x * (1.f + sc2.x) + sh2.x, y.y * rstd2 * gg.y * (1.f + sc2.y) + sh2.y);
                w2[h * 2 + 1] = pk2(y.z * rstd2 * gg.z * (1.f + sc2.z) + sh2.z, y.w * rstd2 * gg.w * (1.f + sc2.w) + sh2.w);
            }
            uint4 wv; wv.x = w[0]; wv.y = w[1]; wv.z = w[2]; wv.w = w[3];
            *(uint4*)(hout + (size_t)row * D + col) = wv;
            if (has2) { uint4 wv2; wv2.x = w2[0]; wv2.y = w2[1]; wv2.z = w2[2]; wv2.w = w2[3]; *(uint4*)(hout + (size_t)row2 * D + col) = wv2; }
        }
    }
}

__device__ __forceinline__ int vcu_of(int bid, int nb) { return (nb % 8 == 0) ? (bid % 8) * (nb / 8) + bid / 8 : bid; }

__device__ __forceinline__ void phase_proj(const Params& p, unsigned char* smem, int bid, int nb) {
    pg8::Gemm g{(const u16*)(p.ws + WS_H), (const u16*)(p.ws + WS_WTIN), T, NPROJ, D};
    pg8::StaticOrder S; S.init(T, NPROJ, nb, bid);
    EpiProj E{(u16*)(p.ws + WS_PROJ)};
    pg8::gemm_phase<EpiProj, pg8::StaticOrder, true, true>((LAS unsigned char*)smem, g, S, E);
}

__device__ __forceinline__ float log2_gamma(int h) { return log2f(1.0f - exp2f(-5.0f - (float)h)); }

constexpr int KT_PITCH = 136;
constexpr int VT_PITCH = 288;

__device__ __forceinline__ void phase_kmean_kv(const Params& p, unsigned char* smem, int bid, int nb) {
    const int tid = opaque_tid(), lane = tid & 63, wid = tid >> 6, fr = lane & 15, fq = lane >> 4;
    const u16* PROJ = (const u16*)(p.ws + WS_PROJ);
    for (int item = bid; item < 512; item += nb) {
        const int b = item >> 8, h = (item >> 5) & 7, blk = item & 31;
        float* red = (float*)smem;
        const int r = tid >> 3, c = tid & 7;
        float s[8] = {0, 0, 0, 0, 0, 0, 0, 0};
#pragma unroll
        for (int ps = 0; ps < 4; ++ps) {
            const size_t row = (size_t)b * SEQ + blk * 256 + ps * 64 + r;
            const uint4 v = *(const uint4*)(PROJ + row * NPROJ + C_KA + h * 64 + c * 8);
            const unsigned w[4] = {v.x, v.y, v.z, v.w};
#pragma unroll
            for (int j = 0; j < 4; ++j) { s[2 * j] += bf2f((u16)(w[j] & 0xffff)); s[2 * j + 1] += bf2f((u16)(w[j] >> 16)); }
        }
#pragma unroll
        for (int j = 0; j < 8; ++j) red[r * 64 + c * 8 + j] = s[j];
        __syncthreads();
        if (tid < 64) {
            float a = 0.f;
            for (int rr = 0; rr < 64; ++rr) a += red[rr * 64 + tid];
            ((float*)(p.ws + WS_KMEAN))[(size_t)item * 64 + tid] = a * (1.0f / 256.0f);
        }
        __syncthreads();
    }
    {
        unsigned char* Ks = smem;
        unsigned char* Vs = smem + 128 * KT_PITCH;
        uint4 kreg0, kreg1, vreg0, vreg1, vreg2, vreg3;
#define KV_LOAD(item_) do { const int b_ = (item_) >> 9, h_ = ((item_) >> 6) & 7, c_ = (item_) & 63; const size_t row0_ = (size_t)b_ * SEQ + c_ * 128; \
            const u16* kp_ = PROJ + (row0_ + (tid >> 3)) * NPROJ + C_KR + h_ * 64 + (tid & 7) * 8; const u16* vp_ = PROJ + (row0_ + (tid >> 4)) * NPROJ + C_VR + h_ * 128 + (tid & 15) * 8; \
            kreg0 = *(const uint4*)kp_; kreg1 = *(const uint4*)(kp_ + (size_t)64 * NPROJ); \
            vreg0 = *(const uint4*)vp_; vreg1 = *(const uint4*)(vp_ + (size_t)32 * NPROJ); vreg2 = *(const uint4*)(vp_ + (size_t)64 * NPROJ); vreg3 = *(const uint4*)(vp_ + (size_t)96 * NPROJ); } while (0)
        int item = bid;
        KV_LOAD(item < 1024 ? item : 0);
        for (; item < 1024; item += nb) {
            const int h = (item >> 6) & 7;
            const float l2g = log2_gamma(h);
            {
#pragma unroll
                for (int i = 0; i < 2; ++i) {
                    const int r = (tid >> 3) + 64 * i, pc = tid & 7;
                    const uint4 v = i ? kreg1 : kreg0;
                    const float dec = exp2f((float)(127 - r) * l2g);
                    const unsigned w[4] = {v.x, v.y, v.z, v.w}; unsigned o[4];
#pragma unroll
                    for (int j = 0; j < 4; ++j) o[j] = pk2(bf2f((u16)(w[j] & 0xffff)) * dec, bf2f((u16)(w[j] >> 16)) * dec);
                    *(uint2*)(Ks + r * KT_PITCH + pc * 16) = make_uint2(o[0], o[1]);
                    *(uint2*)(Ks + r * KT_PITCH + pc * 16 + 8) = make_uint2(o[2], o[3]);
                }
#pragma unroll
                for (int i = 0; i < 4; ++i) {
                    const int r = (tid >> 4) + 32 * i, pc = tid & 15;
                    *(uint4*)(Vs + r * VT_PITCH + pc * 16) = (i == 0) ? vreg0 : (i == 1) ? vreg1 : (i == 2) ? vreg2 : vreg3;
                }
            }
            __syncthreads();
            { const int nx_ = (item + nb < 1024) ? item + nb : item; KV_LOAD(nx_); }
            f32x4 acc[4];
#pragma unroll
            for (int dt = 0; dt < 4; ++dt) acc[dt] = (f32x4){0.f, 0.f, 0.f, 0.f};
            const unsigned char* vb = tr_lane_base(Vs, VT_PITCH, 8 * fq, lane) + wid * 32;
            const unsigned char* kb = tr_lane_base(Ks, KT_PITCH, 8 * fq, lane);
#pragma unroll
            for (int s = 0; s < 4; ++s) {
                const bf16x8 vf = tr_frag2(vb, (32 * s) * VT_PITCH, (32 * s + 4) * VT_PITCH);
#pragma unroll
                for (int dt = 0; dt < 4; ++dt) {
                    const bf16x8 kf = tr_frag2(kb, (32 * s) * KT_PITCH + dt * 32, (32 * s + 4) * KT_PITCH + dt * 32);
                    acc[dt] = __builtin_amdgcn_mfma_f32_16x16x32_bf16(kf, vf, acc[dt], 0, 0, 0);
                }
            }
            float* KV = (float*)(p.ws + WS_KV) + (size_t)item * 8192;
#pragma unroll
            for (int dt = 0; dt < 4; ++dt) *(f32x4*)(KV + (wid * 16 + fr) * 64 + dt * 16 + 4 * fq) = acc[dt];
            __syncthreads();
        }
#undef KV_LOAD
    }
}

__device__ __forceinline__ int alist_off(int n) { return 256 * (31 * n - (n * (n - 1)) / 2); }

__device__ __forceinline__ void phase_gate_scan(const Params& p, unsigned char* smem, int bid, int nb) {
    const int tid = opaque_tid();
    const u16* PROJ = (const u16*)(p.ws + WS_PROJ);
    unsigned* acnt = (unsigned*)(p.ws + WS_CTL);
    unsigned* alist = (unsigned*)(p.ws + WS_ALIST);
    for (int item = bid; item < 256; item += nb) {
        const int b = item >> 7, h = (item >> 4) & 7, qc = item & 15;
        float* km = (float*)smem;
        unsigned* lcnt = (unsigned*)(smem + 8192);
        unsigned* lbase = lcnt + 32;
        for (int i = tid; i < 2048; i += NT) km[i] = ((const float*)(p.ws + WS_KMEAN))[(size_t)((b * 8 + h) * 32) * 64 + i];
        if (tid < 32) lcnt[tid] = 0;
        __syncthreads();
        const int t = qc * 512 + tid, tb = t >> 8;
        float q[64];
        {
            const u16* qp = PROJ + ((size_t)b * SEQ + t) * NPROJ + C_QA + h * 64;
#pragma unroll
            for (int i = 0; i < 8; ++i) {
                const uint4 v = *(const uint4*)(qp + i * 8);
                const unsigned w[4] = {v.x, v.y, v.z, v.w};
#pragma unroll
                for (int j = 0; j < 4; ++j) { q[i * 8 + 2 * j] = bf2f((u16)(w[j] & 0xffff)); q[i * 8 + 2 * j + 1] = bf2f((u16)(w[j] >> 16)); }
            }
        }
        float v0 = -3e38f, v1 = -3e38f, v2 = -3e38f; int i0 = 0, i1 = 0, i2 = 0;
        for (int n = 0; n < tb; ++n) {
            float g = 0.f;
#pragma unroll
            for (int d = 0; d < 64; ++d) g += q[d] * km[n * 64 + d];
            if (g > v0) { v2 = v1; i2 = i1; v1 = v0; i1 = i0; v0 = g; i0 = n; }
            else if (g > v1) { v2 = v1; i2 = i1; v1 = g; i1 = n; }
            else if (g > v2) { v2 = g; i2 = n; }
        }
        const int nsel = tb < 3 ? tb : 3;
        unsigned lp0 = 0, lp1 = 0, lp2 = 0;
        if (nsel > 0) lp0 = atomicAdd(&lcnt[i0], 1u);
        if (nsel > 1) lp1 = atomicAdd(&lcnt[i1], 1u);
        if (nsel > 2) lp2 = atomicAdd(&lcnt[i2], 1u);
        __syncthreads();
        if (tid < 32) lbase[tid] = lcnt[tid] ? atomicAdd(&acnt[(b * 8 + h) * 32 + tid], lcnt[tid]) : 0u;
        __syncthreads();
        unsigned* lst = alist + (size_t)(b * 8 + h) * ALIST_PER_BH;
        if (nsel > 0) lst[alist_off(i0) + lbase[i0] + lp0] = (unsigned)t | (0u << 16);
        if (nsel > 1) lst[alist_off(i1) + lbase[i1] + lp1] = (unsigned)t | (1u << 16);
        if (nsel > 2) lst[alist_off(i2) + lbase[i2] + lp2] = (unsigned)t | (2u << 16);
        __syncthreads();
    }
    for (int idx = bid * NT + tid; idx < 16 * 8192; idx += nb * NT) {
        const int bh = idx >> 13, el = idx & 8191, h = bh & 7;
        const float cd = exp2f(128.0f * log2_gamma(h));
        const float* KV = (const float*)(p.ws + WS_KV) + (size_t)bh * 64 * 8192 + el;
        u16* SP = (u16*)(p.ws + WS_SPREV) + (size_t)bh * 64 * 8192 + el;
        float s = 0.f;
#pragma unroll 8
        for (int c = 0; c < 64; ++c) { SP[(size_t)c * 8192] = f2bf(s); s = cd * s + KV[(size_t)c * 8192]; }
    }
}

__device__ __forceinline__ void attn_wave(const Params& p, const unsigned char* Ks, const unsigned char* Vs, int b, int h, int tq  , bool valid, int kblk, int slot,
                                          int ntmax, bool causal, int lane) {
    const int fr = lane & 15, fq = lane >> 4;
    const u16* PROJ = (const u16*)(p.ws + WS_PROJ);
    const size_t qrow = (size_t)b * SEQ + tq;
    bf16x8 qf[2];
#pragma unroll
    for (int ks = 0; ks < 2; ++ks) qf[ks] = *(const bf16x8*)(PROJ + qrow * NPROJ + C_QA + h * 64 + ks * 32 + fq * 8);
    f32x4 s[16];
    const unsigned char* kb[2] = {Ks + swz_off(fr, fq), Ks + swz_off(fr, 4 + fq)};
#pragma unroll
    for (int nt = 0; nt < 16; ++nt) {
        s[nt] = (f32x4){0.f, 0.f, 0.f, 0.f};
        if (nt <= ntmax) {
#pragma unroll
            for (int ks = 0; ks < 2; ++ks) {
                const bf16x8 kf = *(const bf16x8*)(kb[ks] + nt * 2048);
                s[nt] = __builtin_amdgcn_mfma_f32_16x16x32_bf16(kf, qf[ks], s[nt], 0, 0, 0);
            }
        }
        if ((nt & 3) == 3) __builtin_amdgcn_sched_barrier(0);
    }
    const float slope = exp2f(-(float)(h + 1));
    const int ql = tq - kblk * 256;
    float m = -1e30f;
#pragma unroll
    for (int nt = 0; nt < 16; ++nt) {
#pragma unroll
        for (int j = 0; j < 4; ++j) {
            const int key = nt * 16 + 4 * fq + j;
            float v = s[nt][j] * 0.125f - slope * (float)(ql - key);
            if (nt > ntmax || (causal && key > ql)) v = -1e30f;
            s[nt][j] = v; m = fmaxf(m, v);
        }
    }
    m = rows4_max(m);
    float l = 0.f;
#pragma unroll
    for (int nt = 0; nt < 16; ++nt)
#pragma unroll
        for (int j = 0; j < 4; ++j) { const float e = (s[nt][j] > -1e29f) ? __expf(s[nt][j] - m) : 0.f; s[nt][j] = e; l += e; }
    l = rows4_sum(l);
    f32x4 o[4];
#pragma unroll
    for (int dt = 0; dt < 4; ++dt) o[dt] = (f32x4){0.f, 0.f, 0.f, 0.f};
    const unsigned char* vb = tr_lane_base(Vs, KT_PITCH, 4 * fq, lane);
#pragma unroll
    for (int st = 0; st < 8; ++st) {
        if (2 * st <= ntmax) {
            bf16x8 pf;
            {
                const unsigned a0 = pk2(s[2 * st][0], s[2 * st][1]), a1 = pk2(s[2 * st][2], s[2 * st][3]);
                const unsigned b0 = pk2(s[2 * st + 1][0], s[2 * st + 1][1]), b1 = pk2(s[2 * st + 1][2], s[2 * st + 1][3]);
                pf = (bf16x8){(short)(a0 & 0xffff), (short)(a0 >> 16), (short)(a1 & 0xffff), (short)(a1 >> 16), (short)(b0 & 0xffff), (short)(b0 >> 16), (short)(b1 & 0xffff), (short)(b1 >> 16)};
            }
#pragma unroll
            for (int dt = 0; dt < 4; ++dt) {
                const bf16x8 vf = tr_frag2(vb, (32 * st) * KT_PITCH + dt * 32, (32 * st + 16) * KT_PITCH + dt * 32);
                o[dt] = __builtin_amdgcn_mfma_f32_16x16x32_bf16(vf, pf, o[dt], 0, 0, 0);
            }
        }
        if (st & 1) __builtin_amdgcn_sched_barrier(0);
    }
    if (valid) {
        const float inv = 1.0f / l;
        const size_t pidx = ((qrow * 8 + h) * 4 + slot);
        u16* OP = (u16*)(p.ws + WS_OPART) + pidx * 64;
#pragma unroll
        for (int dt = 0; dt < 4; ++dt) {
            uint2 w; w.x = pk2(o[dt][0] * inv, o[dt][1] * inv); w.y = pk2(o[dt][2] * inv, o[dt][3] * inv);
            *(uint2*)(OP + dt * 16 + 4 * fq) = w;
        }
        if (fq == 0) { float2 ml; ml.x = m; ml.y = l; *(float2*)((float*)(p.ws + WS_ML) + pidx * 2) = ml; }
    }
}


template <bool CAUSAL>
__device__ __forceinline__ void attn_wave2(const Params& p, unsigned lds_k, unsigned lds_v, const bf16x8 (&qf)[2], int b, int h, int tq, bool valid, int kblk, int slot,
                                           int ntmax_rt, int lane) {
    const int ntmax = CAUSAL ? ntmax_rt : 15; constexpr bool causal = CAUSAL;
    const int fr = lane & 15, fq = lane >> 4;
    const size_t qrow = (size_t)b * SEQ + tq;
    f32x4 s[16];
    const LAS unsigned char* kb0 = (const LAS unsigned char*)(size_t)(lds_k + swz_off(fr, fq));
    const LAS unsigned char* kb1 = (const LAS unsigned char*)(size_t)(lds_k + swz_off(fr, 4 + fq));
#pragma unroll
    for (int nt = 0; nt < 16; ++nt) {
        s[nt] = (f32x4){0.f, 0.f, 0.f, 0.f};
        if (nt <= ntmax) {
            const bf16x8 k0 = *(const LAS bf16x8*)(kb0 + nt * 2048), k1 = *(const LAS bf16x8*)(kb1 + nt * 2048);
            s[nt] = __builtin_amdgcn_mfma_f32_16x16x32_bf16(k0, qf[0], s[nt], 0, 0, 0);
            s[nt] = __builtin_amdgcn_mfma_f32_16x16x32_bf16(k1, qf[1], s[nt], 0, 0, 0);
        }
        if ((nt & 3) == 3) __builtin_amdgcn_sched_barrier(0);
    }
    const float slope2 = exp2f(-(float)(h + 1)) * 1.44269504f, c1 = 0.125f * 1.44269504f;
    const int ql = tq - kblk * 256;
    const float kbase = slope2 * (float)(4 * fq - ql);
    float m = -1e30f;
    if (!causal) {
        float mp[4] = {-1e30f, -1e30f, -1e30f, -1e30f};
#pragma unroll
        for (int nt = 0; nt < 16; ++nt) {
#pragma unroll
            for (int j = 0; j < 4; ++j) { const float v = fmaf(s[nt][j], c1, kbase + slope2 * (float)(16 * nt + j)); s[nt][j] = v; mp[j] = fmaxf(mp[j], v); }
        }
        m = fmaxf(fmaxf(mp[0], mp[1]), fmaxf(mp[2], mp[3]));
    } else {
#pragma unroll
        for (int nt = 0; nt < 16; ++nt) {
#pragma unroll
            for (int j = 0; j < 4; ++j) {
                const int key = nt * 16 + 4 * fq + j;
                float v = fmaf(s[nt][j], c1, kbase + slope2 * (float)(16 * nt + j));
                if (nt > ntmax || key > ql) v = -1e30f;
                s[nt][j] = v; m = fmaxf(m, v);
            }
        }
    }
    m = rows4_max(m);
    float lp[4] = {0.f, 0.f, 0.f, 0.f};
#pragma unroll
    for (int nt = 0; nt < 16; ++nt)
#pragma unroll
        for (int j = 0; j < 4; ++j) { const float e = __builtin_amdgcn_exp2f(s[nt][j] - m); s[nt][j] = e; lp[j] += e; }
    float l = (lp[0] + lp[1]) + (lp[2] + lp[3]);
    l = rows4_sum(l);
    m *= 0.69314718f;
    f32x4 o[4];
#pragma unroll
    for (int dt = 0; dt < 4; ++dt) o[dt] = (f32x4){0.f, 0.f, 0.f, 0.f};
    const int i16 = lane & 15, q4 = i16 >> 2, p4 = i16 & 3, vmask = ((2 * fq + (q4 >> 1)) & 3) << 1;
    unsigned va[4];
#pragma unroll
    for (int dt = 0; dt < 4; ++dt) va[dt] = lds_v + (unsigned)((4 * fq + q4) * 128 + ((((dt * 2 + (p4 >> 1)) ^ vmask)) << 4) + (p4 & 1) * 8);
#pragma unroll
    for (int st = 0; st < 8; ++st) {
        if (2 * st <= ntmax) {
            bf16x8 pf;
            {
                const unsigned a0 = pk2(s[2 * st][0], s[2 * st][1]), a1 = pk2(s[2 * st][2], s[2 * st][3]);
                const unsigned b0 = pk2(s[2 * st + 1][0], s[2 * st + 1][1]), b1 = pk2(s[2 * st + 1][2], s[2 * st + 1][3]);
                pf = (bf16x8){(short)(a0 & 0xffff), (short)(a0 >> 16), (short)(a1 & 0xffff), (short)(a1 >> 16), (short)(b0 & 0xffff), (short)(b0 >> 16), (short)(b1 & 0xffff), (short)(b1 >> 16)};
            }
            bf16x4 tl[4], th[4];
            TR_READ_ASM(tl[0], va[0], st * 4096); TR_READ_ASM(th[0], va[0], st * 4096 + 2048);
            TR_READ_ASM(tl[1], va[1], st * 4096); TR_READ_ASM(th[1], va[1], st * 4096 + 2048);
            TR_READ_ASM(tl[2], va[2], st * 4096); TR_READ_ASM(th[2], va[2], st * 4096 + 2048);
            TR_READ_ASM(tl[3], va[3], st * 4096); TR_READ_ASM(th[3], va[3], st * 4096 + 2048);
            asm volatile("s_waitcnt lgkmcnt(0)" : "+v"(tl[0]), "+v"(tl[1]), "+v"(tl[2]), "+v"(tl[3]), "+v"(th[0]), "+v"(th[1]), "+v"(th[2]), "+v"(th[3]) :: "memory");
            __builtin_amdgcn_sched_barrier(0);
#pragma unroll
            for (int dt = 0; dt < 4; ++dt) {
                const bf16x8 vf = (bf16x8){tl[dt][0], tl[dt][1], tl[dt][2], tl[dt][3], th[dt][0], th[dt][1], th[dt][2], th[dt][3]};
                o[dt] = __builtin_amdgcn_mfma_f32_16x16x32_bf16(vf, pf, o[dt], 0, 0, 0);
            }
        }
    }
    if (valid) {
        const float inv = 1.0f / l;
        const size_t pidx = ((qrow * 8 + h) * 4 + slot);
        u16* OP = (u16*)(p.ws + WS_OPART) + pidx * 64;
#pragma unroll
        for (int dt = 0; dt < 4; ++dt) {
            uint2 w; w.x = pk2(o[dt][0] * inv, o[dt][1] * inv); w.y = pk2(o[dt][2] * inv, o[dt][3] * inv);
            *(uint2*)(OP + dt * 16 + 4 * fq) = w;
        }
        if (fq == 0) { float2 ml; ml.x = m; ml.y = l; *(float2*)((float*)(p.ws + WS_ML) + pidx * 2) = ml; }
    }
}

__device__ __forceinline__ void load_kv_block(const Params& p, unsigned char* Ks, unsigned char* Vs, int b, int h, int kblk) {
    const u16* PROJ = (const u16*)(p.ws + WS_PROJ);
    const int tid = opaque_tid();
#pragma unroll
    for (int i = 0; i < 4; ++i) {
        const int r = (tid >> 3) + 64 * i, pc = tid & 7;
        const size_t row = (size_t)b * SEQ + kblk * 256 + r;
        const uint4 kv = *(const uint4*)(PROJ + row * NPROJ + C_KA + h * 64 + pc * 8);
        const uint4 vv = *(const uint4*)(PROJ + row * NPROJ + C_VA + h * 64 + pc * 8);
        *(uint4*)(Ks + swz_off(r, pc)) = kv;
        *(uint2*)(Vs + r * KT_PITCH + pc * 16) = make_uint2(vv.x, vv.y);
        *(uint2*)(Vs + r * KT_PITCH + pc * 16 + 8) = make_uint2(vv.z, vv.w);
    }
}

__device__ __forceinline__ void phase_attn_ret(const Params& p, unsigned char* smem, int bid, int nb) {
    const int tid = opaque_tid(), lane = tid & 63, wid = tid >> 6, fr = lane & 15, fq = lane >> 4;
    const u16* PROJ = (const u16*)(p.ws + WS_PROJ);
    const unsigned* acnt = (const unsigned*)(p.ws + WS_CTL);
    const unsigned* alist = (const unsigned*)(p.ws + WS_ALIST);
    int* pref = (int*)(smem + 72 * 1024);
    {
        const int c = (int)acnt[tid];
        pref[tid + 1] = (c + 127) >> 7;
        if (tid == 0) pref[0] = 0;
        __syncthreads();
        for (int off = 1; off < 512; off <<= 1) {
            const int v = pref[tid + 1] + ((tid >= off) ? pref[tid + 1 - off] : 0);
            __syncthreads();
            pref[tid + 1] = v;
            __syncthreads();
        }
    }
    const int n_sel = __builtin_amdgcn_readfirstlane(pref[512]);
    const int n_own = 1024, n_ret = 1024;
    const int total = n_sel + n_own + n_ret;
    (void)total;
    {
        const int n_att = n_sel + n_own;
        const unsigned lds0 = (unsigned)(unsigned long long)(LAS unsigned char*)smem;
        const int wu = __builtin_amdgcn_readfirstlane(wid);
        int* pref2 = (int*)(smem + 135168);
        __syncthreads();
        int* cnt2 = pref2 + 516;
        for (int i = tid; i < 513; i += NT) pref2[i] = pref[i];
        cnt2[tid] = (int)acnt[tid];
        __syncthreads();
#define AT_DECODE(item_, B, H, KB, NTM, CAUS, VALID, ENT) do { \
            if ((item_) < n_sel) { int lo_ = 0, hi_ = 512; while (hi_ - lo_ > 1) { const int mid_ = (lo_ + hi_) >> 1; if (pref2[mid_] <= (item_)) lo_ = mid_; else hi_ = mid_; } \
                const int bk_ = __builtin_amdgcn_readfirstlane(lo_), tile_ = (item_) - __builtin_amdgcn_readfirstlane(pref2[bk_]); \
                B = bk_ >> 8; H = (bk_ >> 5) & 7; KB = bk_ & 31; NTM = 15; CAUS = false; \
                const int cnt_ = __builtin_amdgcn_readfirstlane(cnt2[bk_]); const int qi_ = tile_ * 128 + wid * 16 + fr; VALID = qi_ < cnt_; \
                ENT = alist[(size_t)(B * 8 + H) * ALIST_PER_BH + alist_off(KB) + (VALID ? qi_ : 0)]; } \
            else { const int it_ = (item_) - n_sel; const int bk_ = it_ >> 1, half_ = it_ & 1; B = bk_ >> 8; H = (bk_ >> 5) & 7; KB = bk_ & 31; \
                ENT = (unsigned)(KB * 256 + half_ * 128 + wid * 16 + fr) | (3u << 16); NTM = half_ * 8 + wu; CAUS = true; VALID = true; } } while (0)
#define AT_ISSUE_KV(B, H, KB, st_) do { const int lsub_ = lane >> 3, lpp_ = lane & 7; \
            _Pragma("unroll") for (int i_ = 0; i_ < 4; ++i_) { const int r_ = (i_ * 8 + wu) * 8 + lsub_; \
                const u16* rp_ = PROJ + ((size_t)(B) * SEQ + (KB) * 256 + r_) * NPROJ + (H) * 64; \
                __builtin_amdgcn_global_load_lds((const unsigned*)(rp_ + C_KA + ((lpp_ ^ (r_ & 7)) * 8)), (LAS unsigned*)(smem + (st_) * 65536 + (i_ * 8 + wu) * 1024), 16, 0, 0); \
                __builtin_amdgcn_global_load_lds((const unsigned*)(rp_ + C_VA + ((lpp_ ^ (((r_ >> 1) & 3) << 1)) * 8)), (LAS unsigned*)(smem + (st_) * 65536 + 32768 + (i_ * 8 + wu) * 1024), 16, 0, 0); } } while (0)
        int item = bid, st = 0;
        int cb = 0, ch = 0, ckb = 0, cntm = 15; bool ccaus = false, cvalid = false; unsigned cent = 0u;
        int db = 0, dh = 0, dkb = 0, dntm = 15; bool dcaus = false, dvalid = false; unsigned dent = 0u;
        bf16x8 qf[2] = {};
        if (item < n_att) {
            AT_DECODE(item, cb, ch, ckb, cntm, ccaus, cvalid, cent);
            AT_ISSUE_KV(cb, ch, ckb, 0);
#pragma unroll
            for (int ks = 0; ks < 2; ++ks) qf[ks] = *(const bf16x8*)(PROJ + ((size_t)cb * SEQ + (int)(cent & 0xffffu)) * NPROJ + C_QA + ch * 64 + ks * 32 + fq * 8);
            if (item + nb < n_att) AT_DECODE(item + nb, db, dh, dkb, dntm, dcaus, dvalid, dent);
        }
        while (item < n_att) {
            asm volatile("s_waitcnt vmcnt(0)" : "+v"(qf[0]), "+v"(qf[1]), "+v"(dent) :: "memory");
            __syncthreads();
            const int item1 = item + nb, item2 = item + 2 * nb;
            bf16x8 qn[2] = {qf[0], qf[1]};
            if (item1 < n_att) {
                AT_ISSUE_KV(db, dh, dkb, st ^ 1);
#pragma unroll
                for (int ks = 0; ks < 2; ++ks) qn[ks] = *(const bf16x8*)(PROJ + ((size_t)db * SEQ + (int)(dent & 0xffffu)) * NPROJ + C_QA + dh * 64 + ks * 32 + fq * 8);
            }
            int eb = 0, eh = 0, ekb = 0, entm = 15; bool ecaus = false, evalid = false; unsigned eent = 0u;
            if (item2 < n_att) AT_DECODE(item2, eb, eh, ekb, entm, ecaus, evalid, eent);
            if (ccaus) attn_wave2<true>(p, lds0 + st * 65536, lds0 + st * 65536 + 32768, qf, cb, ch, (int)(cent & 0xffffu), cvalid, ckb, (int)(cent >> 16), cntm, lane);
            else if (__ballot(cvalid) != 0ull) attn_wave2<false>(p, lds0 + st * 65536, lds0 + st * 65536 + 32768, qf, cb, ch, (int)(cent & 0xffffu), cvalid, ckb, (int)(cent >> 16), cntm, lane);
            cb = db; ch = dh; ckb = dkb; cntm = dntm; ccaus = dcaus; cvalid = dvalid; cent = dent; qf[0] = qn[0]; qf[1] = qn[1];
            db = eb; dh = eh; dkb = ekb; dntm = entm; dcaus = ecaus; dvalid = evalid; dent = eent;
            st ^= 1; item = item1;
        }
        asm volatile("s_waitcnt vmcnt(0)" ::: "memory");
        __syncthreads();
#undef AT_DECODE
#undef AT_ISSUE_KV
    }
    uint4 rk0, rk1, rs0, rs1, rv0, rv1, rv2, rv3; bf16x8 nq0, nq1; uint2 ng[8];
#define RT_LOADALL(it_) do { const int b_ = (it_) >> 9, h_ = ((it_) >> 6) & 7, c_ = (it_) & 63; const size_t row0_ = (size_t)b_ * SEQ + c_ * 128; \
        const u16* SP_ = (const u16*)(p.ws + WS_SPREV) + (size_t)(it_) * 8192; \
        const u16* kp_ = PROJ + (row0_ + (tid >> 3)) * NPROJ + C_KR + h_ * 64 + (tid & 7) * 8; const u16* sp_ = SP_ + (tid >> 3) * 64 + (tid & 7) * 8; \
        const u16* vp_ = PROJ + (row0_ + (tid >> 4)) * NPROJ + C_VR + h_ * 128 + (tid & 15) * 8; \
        rk0 = *(const uint4*)kp_; rk1 = *(const uint4*)(kp_ + (size_t)64 * NPROJ); rs0 = *(const uint4*)sp_; rs1 = *(const uint4*)(sp_ + 64 * 64); \
        rv0 = *(const uint4*)vp_; rv1 = *(const uint4*)(vp_ + (size_t)32 * NPROJ); rv2 = *(const uint4*)(vp_ + (size_t)64 * NPROJ); rv3 = *(const uint4*)(vp_ + (size_t)96 * NPROJ); \
        const u16* qp_ = PROJ + (row0_ + wid * 16 + fr) * NPROJ; \
        nq0 = *(const bf16x8*)(qp_ + C_QR + h_ * 64 + fq * 8); nq1 = *(const bf16x8*)(qp_ + C_QR + h_ * 64 + 32 + fq * 8); \
        _Pragma("unroll") for (int et_ = 0; et_ < 8; ++et_) ng[et_] = *(const uint2*)(qp_ + C_GR + h_ * 128 + et_ * 16 + 4 * fq); } while (0)
    const int it_first = (bid + nb - ((n_sel + n_own) % nb)) % nb;
    RT_LOADALL(it_first < n_ret ? it_first : 0);
    for (int it = it_first; it < n_ret; it += nb) {
        {
            const int b = it >> 9, h = (it >> 6) & 7, c = it & 63;
            unsigned char* Ks = smem;
            unsigned char* Ss = smem + 16384;
            unsigned char* Vs = smem + 32768;
            const size_t row0 = (size_t)b * SEQ + c * 128;
            const int m = wid * 16 + fr;
            bf16x8 qf[2] = {nq0, nq1};
            uint2 gq[8];
#pragma unroll
            for (int et = 0; et < 8; ++et) gq[et] = ng[et];
            {
                const int r = tid >> 3, pc = tid & 7;
                *(uint4*)(Ks + swz_off(r, pc)) = rk0; *(uint4*)(Ks + swz_off(r + 64, pc)) = rk1;
                *(uint4*)(Ss + swz_off(r, pc)) = rs0; *(uint4*)(Ss + swz_off(r + 64, pc)) = rs1;
                const int rv_ = tid >> 4, pv_ = tid & 15;
                *(uint4*)(Vs + rv_ * VT_PITCH + pv_ * 16) = rv0; *(uint4*)(Vs + (rv_ + 32) * VT_PITCH + pv_ * 16) = rv1;
                *(uint4*)(Vs + (rv_ + 64) * VT_PITCH + pv_ * 16) = rv2; *(uint4*)(Vs + (rv_ + 96) * VT_PITCH + pv_ * 16) = rv3;
            }
            __syncthreads();
            { const int nx_ = (it + nb < n_ret) ? it + nb : it; RT_LOADALL(nx_); }
            const float l2g = log2_gamma(h);
            f32x4 o[8];
#pragma unroll
            for (int et = 0; et < 8; ++et) {
                o[et] = (f32x4){0.f, 0.f, 0.f, 0.f};
#pragma unroll
                for (int ks = 0; ks < 2; ++ks) {
                    const bf16x8 sf = *(const bf16x8*)(Ss + swz_off(fr, ks * 4 + fq) + et * 2048);
                    o[et] = __builtin_amdgcn_mfma_f32_16x16x32_bf16(sf, qf[ks], o[et], 0, 0, 0);
                }
            }
            const float qdec = exp2f((float)(m + 1) * l2g);
#pragma unroll
            for (int et = 0; et < 8; ++et) o[et] = o[et] * qdec;
            f32x4 s[8];
#pragma unroll
            for (int nt = 0; nt < 8; ++nt) {
                s[nt] = (f32x4){0.f, 0.f, 0.f, 0.f};
                if (nt <= wid) {
#pragma unroll
                    for (int ks = 0; ks < 2; ++ks) {
                        const bf16x8 kf = *(const bf16x8*)(Ks + swz_off(fr, ks * 4 + fq) + nt * 2048);
                        s[nt] = __builtin_amdgcn_mfma_f32_16x16x32_bf16(kf, qf[ks], s[nt], 0, 0, 0);
                    }
#pragma unroll
                    for (int j = 0; j < 4; ++j) {
                        const int n = nt * 16 + 4 * fq + j;
                        s[nt][j] = (n <= m) ? s[nt][j] * exp2f((float)(m - n) * l2g) : 0.f;
                    }
                }
            }
            const unsigned char* vb = tr_lane_base(Vs, VT_PITCH, 4 * fq, lane);
#pragma unroll
            for (int st = 0; st < 4; ++st) {
                if (2 * st <= wid) {
                    bf16x8 pf;
                    {
                        const unsigned a0 = pk2(s[2 * st][0], s[2 * st][1]), a1 = pk2(s[2 * st][2], s[2 * st][3]);
                        const unsigned b0 = pk2(s[2 * st + 1][0], s[2 * st + 1][1]), b1 = pk2(s[2 * st + 1][2], s[2 * st + 1][3]);
                        pf = (bf16x8){(short)(a0 & 0xffff), (short)(a0 >> 16), (short)(a1 & 0xffff), (short)(a1 >> 16), (short)(b0 & 0xffff), (short)(b0 >> 16), (short)(b1 & 0xffff), (short)(b1 >> 16)};
                    }
#pragma unroll
                    for (int et = 0; et < 8; ++et) {
                        const bf16x8 vf = tr_frag2(vb, (32 * st) * VT_PITCH + et * 32, (32 * st + 16) * VT_PITCH + et * 32);
                        o[et] = __builtin_amdgcn_mfma_f32_16x16x32_bf16(vf, pf, o[et], 0, 0, 0);
                    }
                }
            }
            float sum = 0.f;
#pragma unroll
            for (int et = 0; et < 8; ++et) sum += (o[et][0] + o[et][1]) + (o[et][2] + o[et][3]);
            sum = rows4_sum(sum);
            const float mu = sum * (1.0f / 128.0f);
            float var = 0.f;
#pragma unroll
            for (int et = 0; et < 8; ++et)
#pragma unroll
                for (int j = 0; j < 4; ++j) { const float dlt = o[et][j] - mu; var += dlt * dlt; }
            var = rows4_sum(var);
            const float rstd = rsqrtf(var * (1.0f / 128.0f) + 1e-6f);
            u16* YR = (u16*)(p.ws + WS_YR) + (row0 + m) * 1024 + h * 128;
#pragma unroll
            for (int et = 0; et < 8; ++et) {
                const uint2 g = gq[et];
                const float g0 = bf2f((u16)(g.x & 0xffff)), g1 = bf2f((u16)(g.x >> 16)), g2 = bf2f((u16)(g.y & 0xffff)), g3 = bf2f((u16)(g.y >> 16));
                uint2 w; w.x = pk2((o[et][0] - mu) * rstd * g0, (o[et][1] - mu) * rstd * g1); w.y = pk2((o[et][2] - mu) * rstd * g2, (o[et][3] - mu) * rstd * g3);
                *(uint2*)(YR + et * 16 + 4 * fq) = w;
            }
            __syncthreads();
        }
    }
#undef RT_LOADALL
}

__device__ __forceinline__ void combine_one(const u16* OP, const float* ML, u16* YA, size_t idx) {
    const size_t th = idx >> 3; const int pc = (int)(idx & 7);
    const int t = (int)((th >> 3) & (SEQ - 1)), tb = t >> 8, nsel = tb < 3 ? tb : 3;
    const float* ml = ML + th * 8;
    const float4 mlA = *(const float4*)ml, mlB = *(const float4*)(ml + 4);
    uint4 pv[4];
#pragma unroll
    for (int s = 0; s < 4; ++s) pv[s] = *(const uint4*)(OP + (th * 4 + ((s == 3 || s < nsel) ? s : 3)) * 64 + pc * 8);
    const float mlv[8] = {mlA.x, mlA.y, mlA.z, mlA.w, mlB.x, mlB.y, mlB.z, mlB.w};
    float mm[4], ll[4]; float M = -1e30f;
#pragma unroll
    for (int s = 0; s < 4; ++s) { const bool on = (s == 3) || (s < nsel); mm[s] = on ? mlv[s * 2] : -1e30f; ll[s] = on ? mlv[s * 2 + 1] : 0.f; M = fmaxf(M, mm[s]); }
    float acc[8] = {0, 0, 0, 0, 0, 0, 0, 0}; float wsum = 0.f;
#pragma unroll
    for (int s = 0; s < 4; ++s) {
        const bool on = (s == 3) || (s < nsel);
        const float w = on ? ll[s] * __expf(mm[s] - M) : 0.f; wsum += w;
        const unsigned ww[4] = {pv[s].x, pv[s].y, pv[s].z, pv[s].w};
#pragma unroll
        for (int j = 0; j < 4; ++j) { acc[2 * j] += w * bf2f((u16)(ww[j] & 0xffff)); acc[2 * j + 1] += w * bf2f((u16)(ww[j] >> 16)); }
    }
    const float inv = 1.0f / wsum;
    uint4 o; o.x = pk2(acc[0] * inv, acc[1] * inv); o.y = pk2(acc[2] * inv, acc[3] * inv); o.z = pk2(acc[4] * inv, acc[5] * inv); o.w = pk2(acc[6] * inv, acc[7] * inv);
    *(uint4*)(YA + th * 64 + pc * 8) = o;
}
__device__ __forceinline__ void phase_combine(const Params& p, int bid, int nb) {
    const u16* OP = (const u16*)(p.ws + WS_OPART); const float* ML = (const float*)(p.ws + WS_ML); u16* YA = (u16*)(p.ws + WS_YA);
    const size_t stride = (size_t)nb * NT;
#pragma unroll 2
    for (size_t idx = (size_t)bid * NT + opaque_tid(); idx < (size_t)T * 64; idx += stride) combine_one(OP, ML, YA, idx);
}

__device__ __forceinline__ void phase_merge(const Params& p, unsigned char* smem, int bid, int nb) {
    const u16* PROJ = (const u16*)(p.ws + WS_PROJ); u16* MG = (u16*)(p.ws + WS_MERGED);
    {
        pg8::Gemm g{(const u16*)(p.ws + WS_YA), (const u16*)(p.ws + WS_WTPA), T, 1024, 512};
        pg8::StaticOrder S; S.init(T, 1024, nb, bid);
        EpiMerge<0> E{MG, PROJ};
        pg8::gemm_phase<EpiMerge<0>, pg8::StaticOrder, false, true>((LAS unsigned char*)smem, g, S, E);
    }
    {
        pg8::Gemm g{(const u16*)(p.ws + WS_YR), (const u16*)(p.ws + WS_WTPR), T, 1024, 1024};
        pg8::StaticOrder S; S.init(T, 1024, nb, bid);
        EpiMerge<1> E{MG, PROJ};
        pg8::gemm_phase<EpiMerge<1>, pg8::StaticOrder, false, true>((LAS unsigned char*)smem, g, S, E);
    }
}

__device__ __forceinline__ void phase_outproj(const Params& p, unsigned char* smem, int bid, int nb) {
    pg8::Gemm g{(const u16*)(p.ws + WS_MERGED), (const u16*)(p.ws + WS_WTOUT), T, 1024, 1024};
    pg8::StaticOrder S; S.init(T, 1024, nb, bid);
    EpiOut E{p.x, (const float*)(p.ws + WS_MOD), (float*)(p.ws + WS_X1)};
    pg8::gemm_phase<EpiOut, pg8::StaticOrder, false, true>((LAS unsigned char*)smem, g, S, E);
}

__device__ __forceinline__ void phase_router_gemm(const Params& p, unsigned char* smem, int bid, int nb) {
    pg8::Gemm g{(const u16*)(p.ws + WS_H2), (const u16*)(p.ws + WS_WTRT), T, 768, D};
    pg8::StaticOrder S; S.init(T, 768, nb, bid);
    EpiRouterShared E{(float*)(p.ws + WS_LOGIT), (u16*)(p.ws + WS_GSH)};
    pg8::gemm_phase<EpiRouterShared, pg8::StaticOrder, false, true>((LAS unsigned char*)smem, g, S, E);
}

__device__ __forceinline__ void phase_route_shared(const Params& p, unsigned char* smem, int bid, int nb) {
    const int tid = opaque_tid(), lane = tid & 63, wid = tid >> 6;
    const float* LG = (const float*)(p.ws + WS_LOGIT);
    unsigned* ecnt = (unsigned*)(p.ws + WS_CTL + 20480);
    unsigned* elist = (unsigned*)(p.ws + WS_ELIST); float* WTS = (float*)(p.ws + WS_WTS);
    unsigned* lcnt = (unsigned*)smem;
    unsigned* lbase = lcnt + 256;
    int* sel_e = (int*)(lbase + 256);
    unsigned* sel_p = (unsigned*)(sel_e + 512);
    for (int chunk = bid; chunk < T / 64; chunk += nb) {
        if (tid < 256) lcnt[tid] = 0u;
        __syncthreads();
        {
            const float4 bs = *(const float4*)(p.router_bias + lane * 4);
            const unsigned long long ltm = (1ull << lane) - 1ull;
            float4 lgq[8];
#pragma unroll
            for (int rr = 0; rr < 8; ++rr) lgq[rr] = *(const float4*)(LG + (size_t)(chunk * 64 + wid * 8 + rr) * 256 + lane * 4);
#pragma unroll
            for (int rr = 0; rr < 8; ++rr) {
                const int tl = wid * 8 + rr, token = chunk * 64 + tl;
                const float4 lg = lgq[rr];
                const float sc0 = sigmoidf_(lg.x), sc1 = sigmoidf_(lg.y), sc2 = sigmoidf_(lg.z), sc3 = sigmoidf_(lg.w);
                const float c0 = sc0 + bs.x, c1 = sc1 + bs.y, c2 = sc2 + bs.z, c3 = sc3 + bs.w;
                float m1 = fmaxf(fmaxf(c0, c1), fmaxf(c2, c3)), m2;
                {
                    const float a = fmaxf(c0, c1), a2 = fminf(c0, c1), bq = fmaxf(c2, c3), b2 = fminf(c2, c3);
                    m2 = fmaxf(fminf(a, bq), fmaxf(a2, b2));
                }
#define RT_MERGE(ctrl) do { const float o1 = __int_as_float(__builtin_amdgcn_update_dpp(0, __float_as_int(m1), ctrl, 0xf, 0xf, true)), o2 = __int_as_float(__builtin_amdgcn_update_dpp(0, __float_as_int(m2), ctrl, 0xf, 0xf, true)); \
                    const float n1 = fmaxf(m1, o1), n2 = fmaxf(fminf(m1, o1), fmaxf(m2, o2)); m1 = n1; m2 = n2; } while (0)
                RT_MERGE(0xB1);
                RT_MERGE(0x4E);
                RT_MERGE(0x141);
#undef RT_MERGE
                const float gs = m1 + m2; const int grp = lane >> 3;
                int grank = 0;
#pragma unroll
                for (int g = 0; g < 8; ++g) { const float og = __int_as_float(__builtin_amdgcn_readlane(__float_as_int(gs), g * 8)); grank += (og > gs || (og == gs && g < grp)) ? 1 : 0; }
                const bool gsel = grank < 4;
                unsigned k0, k1, k2, k3;
                { unsigned u = __float_as_uint(c0); k0 = gsel ? ((u & 0x80000000u) ? ~u : (u | 0x80000000u)) : 0u; }
                { unsigned u = __float_as_uint(c1); k1 = gsel ? ((u & 0x80000000u) ? ~u : (u | 0x80000000u)) : 0u; }
                { unsigned u = __float_as_uint(c2); k2 = gsel ? ((u & 0x80000000u) ? ~u : (u | 0x80000000u)) : 0u; }
                { unsigned u = __float_as_uint(c3); k3 = gsel ? ((u & 0x80000000u) ? ~u : (u | 0x80000000u)) : 0u; }
                unsigned cur = 0u;
#define RT_CNT(c_) (__popcll(__ballot(k0 >= (c_))) + __popcll(__ballot(k1 >= (c_))) + __popcll(__ballot(k2 >= (c_))) + __popcll(__ballot(k3 >= (c_))))
#pragma unroll 1
                for (int bb = 30; bb >= 0; bb -= 2) {
                    const unsigned ca = cur | (3u << bb), cb = cur | (2u << bb), cc = cur | (1u << bb);
                    const int na = RT_CNT(ca), nb_ = RT_CNT(cb), nc = RT_CNT(cc);
                    if (na >= 8) { cur = ca; if (na == 8) break; }
                    else if (nb_ >= 8) { cur = cb; if (nb_ == 8) break; }
                    else if (nc >= 8) { cur = cc; if (nc == 8) break; }
                }
#undef RT_CNT
                const int need = 8 - (__popcll(__ballot(k0 > cur)) + __popcll(__ballot(k1 > cur)) + __popcll(__ballot(k2 > cur)) + __popcll(__ballot(k3 > cur)));
                const bool e0 = k0 == cur, e1 = k1 == cur, e2 = k2 == cur, e3 = k3 == cur;
                const int eqb = __popcll(__ballot(e0) & ltm) + __popcll(__ballot(e1) & ltm) + __popcll(__ballot(e2) & ltm) + __popcll(__ballot(e3) & ltm);
                const bool s0 = (k0 > cur) || (e0 && eqb < need);
                const bool s1 = (k1 > cur) || (e1 && eqb + (e0 ? 1 : 0) < need);
                const bool s2 = (k2 > cur) || (e2 && eqb + (e0 ? 1 : 0) + (e1 ? 1 : 0) < need);
                const bool s3 = (k3 > cur) || (e3 && eqb + (e0 ? 1 : 0) + (e1 ? 1 : 0) + (e2 ? 1 : 0) < need);
                const int pb = __popcll(__ballot(s0) & ltm) + __popcll(__ballot(s1) & ltm) + __popcll(__ballot(s2) & ltm) + __popcll(__ballot(s3) & ltm);
                const float ssum = wave_sum((s0 ? sc0 : 0.f) + (s1 ? sc1 : 0.f) + (s2 ? sc2 : 0.f) + (s3 ? sc3 : 0.f));
                const float rn = 2.5f / (ssum + 1e-20f);
                int pos = pb;
                if (s0) { WTS[token * 8 + pos] = sc0 * rn; sel_e[tl * 8 + pos] = lane * 4 + 0; ++pos; }
                if (s1) { WTS[token * 8 + pos] = sc1 * rn; sel_e[tl * 8 + pos] = lane * 4 + 1; ++pos; }
                if (s2) { WTS[token * 8 + pos] = sc2 * rn; sel_e[tl * 8 + pos] = lane * 4 + 2; ++pos; }
                if (s3) { WTS[token * 8 + pos] = sc3 * rn; sel_e[tl * 8 + pos] = lane * 4 + 3; ++pos; }
            }
        }
        __syncthreads();
        sel_p[tid] = atomicAdd(&lcnt[sel_e[tid]], 1u);
        __syncthreads();
        if (tid < 256) lbase[tid] = lcnt[tid] ? atomicAdd(&ecnt[tid * ECNT_STRIDE], lcnt[tid]) : 0u;
        __syncthreads();
        {
            const int e = sel_e[tid];
            elist[(size_t)e * T + lbase[e] + sel_p[tid]] = (unsigned)((chunk * 64 + (tid >> 3)) * 8 + (tid & 7));
        }
        __syncthreads();
    }
}

__device__ __forceinline__ unsigned cvt_pk_bf16_f32(float lo, float hi) { unsigned r; asm("v_cvt_pk_bf16_f32 %0, %1, %2" : "=v"(r) : "v"(lo), "v"(hi)); return r; }

constexpr int EX_STG = 32768 + WB_TILE_BYTES;
constexpr int EX_TAB = 2 * EX_STG;

__device__ __forceinline__ void phase_experts(const Params& p, unsigned char* smem, int bid, int nb) {
    const int tid = opaque_tid(), lane = tid & 63, wid = __builtin_amdgcn_readfirstlane(tid >> 6), wm = wid & 1, wn = wid >> 1, fr = lane & 15, fq = lane >> 4;
    const unsigned char* Hb = (const unsigned char*)(p.ws + WS_H2);
    const unsigned* ecnt = (const unsigned*)(p.ws + WS_CTL + 20480);
    const unsigned* elist = (const unsigned*)(p.ws + WS_ELIST); const float* WTS = (const float*)(p.ws + WS_WTS);
    u16* OS = (u16*)(p.ws + WS_OSLOT);
    unsigned char* Gb = p.ws + WS_GBUF + (size_t)bid * 131072;
    int* pref = (int*)(smem + EX_TAB);
    int* rowtok = pref + 260;
    int* rowslot = rowtok + 256;
    float* roww = (float*)(rowslot + 256);
    int* ordk = (int*)(smem + EX_TAB + 5152);
    int* cntL = ordk + 256;
    {
        int nrb4[4], kmin4[4], k4[4]; float x4[4];
        float fs = 0.f, fk = 0.f;
#pragma unroll
        for (int j = 0; j < 4; ++j) { const int c = (int)ecnt[(lane + 64 * j) * ECNT_STRIDE]; nrb4[j] = (c + 31) >> 5; kmin4[j] = (nrb4[j] + 7) >> 3; fs += (float)nrb4[j]; fk += (float)kmin4[j]; }
        const float tot = wave_sum(fs); const int KM = (int)wave_sum(fk);
        const int R = (KM + nb - 1) / nb; const float target = (float)(R * nb - (nb >= 128 ? 40 : 0));
        const float scale = target / fmaxf(tot, 1.f);
#pragma unroll
        for (int j = 0; j < 4; ++j) x4[j] = (float)nrb4[j] * scale;
        float lo = -1.f;
        {
            float sv = 0.f;
#pragma unroll
            for (int j = 0; j < 4; ++j) sv += (float)max(kmin4[j], (int)x4[j]);
            if (wave_sum(sv) <= target) lo = 0.f;
        }
        if (lo >= 0.f) {
            float hi = 1.f;
            for (int it = 0; it < 12; ++it) {
                const float mid = 0.5f * (lo + hi);
                float sv = 0.f;
#pragma unroll
                for (int j = 0; j < 4; ++j) sv += (float)max(kmin4[j], (int)(x4[j] + mid));
                if (wave_sum(sv) <= target) lo = mid; else hi = mid;
            }
        }
#pragma unroll
        for (int j = 0; j < 4; ++j) k4[j] = (lo >= 0.f) ? max(kmin4[j], (int)(x4[j] + lo)) : kmin4[j];
        if (wid == 0) {
#pragma unroll
            for (int j = 0; j < 4; ++j) rowtok[lane + 64 * j] = (k4[j] << 8) | (k4[j] > 0 ? (nrb4[j] + k4[j] - 1) / k4[j] : 0);
        }
        __syncthreads();
        int my = 0, rank = 0;
        if (tid < 256) {
            my = rowtok[tid]; const int mt = my & 255;
            for (int o = 0; o < 256; ++o) { const int ot = rowtok[o] & 255; rank += (ot > mt || (ot == mt && o < tid)) ? 1 : 0; }
        }
        __syncthreads();
        if (tid < 256) { ordk[rank] = tid | (my & ~255); cntL[tid] = (int)ecnt[tid * ECNT_STRIDE]; }
        __syncthreads();
        if (tid < 256) pref[tid + 1] = ordk[tid] >> 8;
        if (tid == 0) pref[0] = 0;
        __syncthreads();
        for (int off = 1; off < 256; off <<= 1) {
            int v = 0;
            if (tid < 256) v = pref[tid + 1] + ((tid >= off) ? pref[tid + 1 - off] : 0);
            __syncthreads();
            if (tid < 256) pref[tid + 1] = v;
            __syncthreads();
        }
    }
    const int total = __builtin_amdgcn_readfirstlane(pref[256]);
    const unsigned lds0 = (unsigned)(unsigned long long)(LAS unsigned char*)smem;
    const int whalf = wid & 1, wrow0 = (wid >> 1) * 16, sc4 = lane & 31, lrow = lane >> 5;
    const unsigned wvoff1 = (unsigned)(lrow * 256 + sc4 * 4) * 4u, wvoff2 = (unsigned)(lrow * 1024 + sc4 * 4) * 4u;
    const int o4_ = whalf * 32 + sc4, l4_ = (o4_ >> 3) * 8 + (o4_ & 1) * 4 + ((o4_ >> 1) & 3);
    const int cb1 = ((sc4 >> 2) * 32 + (sc4 & 3) * 4 + whalf * 16) * 2, cb2 = l4_ * 8;
    const int wl1 = (wrow0 + lrow) * WB_PITCH + cb1, wl1x = (wrow0 + lrow) * WB_PITCH + (cb1 ^ 128);
    const int wl2 = (wrow0 + lrow) * WB_PITCH + cb2, wl2x = (wrow0 + lrow) * WB_PITCH + (cb2 ^ 128);
    const int lsub = lane >> 3, lpp = lane & 7, csrc = lpp ^ lsub;
    const int ii = lane & 15;
    const int wboff = (8 * fq + (ii >> 2)) * WB_PITCH + ((wn ^ (fq & 1)) * 128) + (ii & 3) * 8;
    const int a0off = swz_off(wm * 16 + fr, fq), a1off = swz_off(wm * 16 + fr, 4 + fq);
#define EX_ISSUE_A(s, stg, G2) do { const int kt_ = (G2) ? (((s) - 32) & 3) : ((s) & 15); \
        if (G2) { const unsigned char* ub_ = (const unsigned char*)Gb + kt_ * 128; unsigned vo_ = aoffG0; asm volatile("" : "+v"(vo_)); \
            _Pragma("unroll") for (int i_ = 0; i_ < 4; ++i_) if ((i_ * 8 + wid) * 8 < nmi * 32) \
                __builtin_amdgcn_global_load_lds((const unsigned*)(ub_ + i_ * 32768 + vo_), (LAS unsigned*)(smem + (stg) * EX_STG + (i_ * 8 + wid) * 1024), 16, 0, 0); } \
        else { const unsigned char* ub_ = Hb + kt_ * 128; \
            _Pragma("unroll") for (int i_ = 0; i_ < 4; ++i_) if ((i_ * 8 + wid) * 8 < nmi * 32) \
                __builtin_amdgcn_global_load_lds((const unsigned*)(ub_ + aoffH[i_]), (LAS unsigned*)(smem + (stg) * EX_STG + (i_ * 8 + wid) * 1024), 16, 0, 0); } } while (0)
#define EX_LOAD_W(s) do { const bool g2_ = (s) >= 32; const int kt_ = g2_ ? (((s) - 32) & 3) : ((s) & 15); const int ps_ = g2_ ? (((s) - 32) >> 2) : ((s) >> 4); \
        const unsigned char* ub_ = g2_ ? (const unsigned char*)(W2 + ps_ * 256 + whalf * 128 + (size_t)(kt_ * 64 + wrow0) * 1024) : (const unsigned char*)(W13u + ps_ * 128 + (size_t)(kt_ * 64 + wrow0) * 256); \
        const unsigned vo_ = g2_ ? wvoff2 : wvoff1; const int ld2_ = g2_ ? 8192 : 2048; \
        _Pragma("unroll") for (int i_ = 0; i_ < 8; ++i_) rw[i_] = *(const f32x4*)(ub_ + (size_t)i_ * ld2_ + vo_); } while (0)
#define EX_ISSUE_A1(i_, s, stg, G2) do { const int kt_ = (G2) ? (((s) - 32) & 3) : ((s) & 15); \
        if ((i_ * 8 + wid) * 8 < nmi * 32) { \
            if (G2) __builtin_amdgcn_global_load_lds((const unsigned*)((const unsigned char*)Gb + kt_ * 128 + i_ * 32768 + aoffG0), (LAS unsigned*)(smem + (stg) * EX_STG + (i_ * 8 + wid) * 1024), 16, 0, 0); \
            else __builtin_amdgcn_global_load_lds((const unsigned*)(Hb + kt_ * 128 + aoffH[i_]), (LAS unsigned*)(smem + (stg) * EX_STG + (i_ * 8 + wid) * 1024), 16, 0, 0); } \
        else if ((i_) < 2) __builtin_amdgcn_global_load_lds((const unsigned*)Hb, (LAS unsigned*)(smem + EX_TAB + 4128), 16, 0, 0); } while (0)
#define EX_LOAD_W1(i_, s) do { const bool g2_ = (s) >= 32; const int kt_ = g2_ ? (((s) - 32) & 3) : ((s) & 15); const int ps_ = g2_ ? (((s) - 32) >> 2) : ((s) >> 4); \
        const unsigned char* ub_ = g2_ ? (const unsigned char*)(W2 + ps_ * 256 + whalf * 128 + (size_t)(kt_ * 64 + wrow0) * 1024) : (const unsigned char*)(W13u + ps_ * 128 + (size_t)(kt_ * 64 + wrow0) * 256); \
        const unsigned vo_ = g2_ ? wvoff2 : wvoff1; const unsigned char* sb_ = ub_ + (size_t)(i_) * (g2_ ? 8192 : 2048); \
        asm volatile("s_nop 4\n\tglobal_load_dwordx4 %0, %1, %2" : "=v"(rw[i_]) : "v"(vo_), "s"(sb_) : "memory"); } while (0)
#define EX_STORE_W1(j_, t, stg) do { const unsigned wa_ = lds0 + (unsigned)((stg) * EX_STG + 32768 + (2 * (j_)) * WB_PITCH) + (unsigned)((j_) < 4 ? (((t) >= 32) ? wl2 : wl1) : (((t) >= 32) ? wl2x : wl1x)); \
        uint2 w_; w_.x = cvt_pk_bf16_f32(rw[j_][0], rw[j_][1]); w_.y = cvt_pk_bf16_f32(rw[j_][2], rw[j_][3]); \
        asm volatile("ds_write_b64 %0, %1" :: "v"(wa_), "v"(w_) : "memory"); } while (0)
#define EX_STORE_W(s, stg) do { unsigned char* wt_ = smem + (stg) * EX_STG + 32768; int lo_ = ((s) >= 32) ? wl2 : wl1, hi_ = ((s) >= 32) ? wl2x : wl1x; asm volatile("" : "+v"(lo_), "+v"(hi_)); \
        _Pragma("unroll") for (int i_ = 0; i_ < 8; ++i_) { uint2 w_; w_.x = cvt_pk_bf16_f32(rw[i_][0], rw[i_][1]); w_.y = cvt_pk_bf16_f32(rw[i_][2], rw[i_][3]); \
            *(uint2*)(wt_ + (i_ < 4 ? lo_ : hi_) + (2 * i_) * WB_PITCH) = w_; } } while (0)
    const int vcx = vcu_of(bid, nb);
#define EX_DECODE(item_, E_, RLO_, NROWS_, NMI_) do { int lo_ = 0, hi_ = 256; \
        while (hi_ - lo_ > 1) { const int mid_ = (lo_ + hi_) >> 1; if (pref[mid_] <= (item_)) lo_ = mid_; else hi_ = mid_; } \
        lo_ = __builtin_amdgcn_readfirstlane(lo_); const int ok_ = __builtin_amdgcn_readfirstlane(ordk[lo_]); \
        E_ = ok_ & 255; const int ntile_ = ok_ >> 8, tile_ = (item_) - __builtin_amdgcn_readfirstlane(pref[lo_]); \
        const int cnt_ = __builtin_amdgcn_readfirstlane(cntL[E_]), nrb_ = (cnt_ + 31) >> 5, rbb_ = nrb_ / ntile_, rbx_ = nrb_ - rbb_ * ntile_;        \
        const int rb0_ = tile_ * rbb_ + min(tile_, rbx_); NMI_ = rbb_ + (tile_ < rbx_ ? 1 : 0); \
        RLO_ = rb0_ * 32; NROWS_ = min(cnt_ - RLO_, NMI_ * 32); } while (0)
    int nx_item = -1; unsigned nx_rid = 0u;
    for (int rnd = 0; rnd * nb < total; ++rnd) {
        const int item = rnd * nb + (rnd == 0 ? vcx : nb - 1 - vcx);
        if (item >= total) continue;
        int e, r_lo, nrows, nmi;
        EX_DECODE(item, e, r_lo, nrows, nmi);
        const float* W1 = p.w1 + (size_t)e * 1024 * 256;
        const float* W3 = p.w3 + (size_t)e * 1024 * 256;
        const float* W2 = p.w2 + (size_t)e * 256 * 1024;
        const float* W13u = whalf ? W3 : W1;
        f32x4 rw[8];
        EX_LOAD_W(0);
        unsigned rid = 0u;
        if (tid < 256) {
            if (tid < nrows) { rid = (nx_item == item) ? nx_rid : elist[(size_t)e * T + r_lo + tid]; rowtok[tid] = (int)(rid >> 3); rowslot[tid] = (int)rid; }
            else { rowtok[tid] = 0; rowslot[tid] = -1; }
        }
        __syncthreads();
        {
            const int it2 = (rnd + 1) * nb + (nb - 1 - vcx);
            if (it2 < total) { int e2, r_lo2, nrows2, nmi2; EX_DECODE(it2, e2, r_lo2, nrows2, nmi2); (void)nmi2; nx_item = it2; nx_rid = (tid < nrows2) ? elist[(size_t)e2 * T + r_lo2 + tid] : 0u; }
        }
        float rwt = 0.f;
        if (tid < nrows && tid < 256) rwt = WTS[rid];
        unsigned aoffH[4];
#pragma unroll
        for (int i = 0; i < 4; ++i) { const int r = (i * 8 + wid) * 8 + lsub; aoffH[i] = (unsigned)rowtok[r] * 2048u + csrc * 16; }
        const unsigned aoffG0 = (unsigned)(wid * 8 + lsub) * 512u + csrc * 16;
        f32x4 acc[8][4];
#pragma unroll
        for (int a = 0; a < 8; ++a)
#pragma unroll
            for (int c = 0; c < 4; ++c) acc[a][c] = (f32x4){0.f, 0.f, 0.f, 0.f};
        EX_ISSUE_A(0, 0, false); EX_STORE_W(0, 0);
        if (tid < 256) roww[tid] = rwt;
        { _Pragma("unroll") for (int j_ = 0; j_ < 8; ++j_) EX_LOAD_W1(j_, 1); }
        asm volatile("s_waitcnt vmcnt(8)" ::: "memory");
        __syncthreads();
#define EX_STEP(s, HASNEXT, NOA, G2) do { const int cur_ = (s) & 1, nxt_ = cur_ ^ 1; const int t2_ = ((s) + 2 < 48) ? (s) + 2 : 47; \
            { int wb_ = wboff, ao0_ = a0off, ao1_ = a1off; asm volatile("" : "+v"(wb_), "+v"(ao0_), "+v"(ao1_)); const unsigned char* As_ = smem + cur_ * EX_STG; \
              const unsigned wsa_ = lds0 + (unsigned)(cur_ * EX_STG + 32768) + (unsigned)wb_; \
              _Pragma("unroll") for (int ks_ = 0; ks_ < 2; ++ks_) { bf16x8 bfr_[4]; \
                { bf16x4 tl_[4], th_[4]; \
                  TR_READ_ASM(tl_[0], wsa_, ks_ * 32 * WB_PITCH + 0); TR_READ_ASM(th_[0], wsa_, (ks_ * 32 + 4) * WB_PITCH + 0); \
                  TR_READ_ASM(tl_[1], wsa_, ks_ * 32 * WB_PITCH + 32); TR_READ_ASM(th_[1], wsa_, (ks_ * 32 + 4) * WB_PITCH + 32); \
                  TR_READ_ASM(tl_[2], wsa_, ks_ * 32 * WB_PITCH + 64); TR_READ_ASM(th_[2], wsa_, (ks_ * 32 + 4) * WB_PITCH + 64); \
                  TR_READ_ASM(tl_[3], wsa_, ks_ * 32 * WB_PITCH + 96); TR_READ_ASM(th_[3], wsa_, (ks_ * 32 + 4) * WB_PITCH + 96); \
                  asm volatile("s_waitcnt lgkmcnt(0)" : "+v"(tl_[0]), "+v"(tl_[1]), "+v"(tl_[2]), "+v"(tl_[3]), "+v"(th_[0]), "+v"(th_[1]), "+v"(th_[2]), "+v"(th_[3]) :: "memory"); \
                  __builtin_amdgcn_sched_barrier(0); \
                  _Pragma("unroll") for (int ni_ = 0; ni_ < 4; ++ni_) bfr_[ni_] = (bf16x8){tl_[ni_][0], tl_[ni_][1], tl_[ni_][2], tl_[ni_][3], th_[ni_][0], th_[ni_][1], th_[ni_][2], th_[ni_][3]}; } \
                _Pragma("unroll") for (int mi_ = 0; mi_ < 8; ++mi_) { if (mi_ < 4 || mi_ < nmi) { const bf16x8 af_ = *(const bf16x8*)(As_ + (ks_ ? ao1_ : ao0_) + mi_ * 4096);        \
                    _Pragma("unroll") for (int ni_ = 0; ni_ < 4; ++ni_) acc[mi_][ni_] = __builtin_amdgcn_mfma_f32_16x16x32_bf16(bfr_[ni_], af_, acc[mi_][ni_], 0, 0, 0); } \
                      \
                    if (ks_ * 8 + mi_ < 4) { if ((HASNEXT) && !(NOA)) EX_ISSUE_A1(ks_ * 8 + mi_, (s) + 1, nxt_, G2); else if (ks_ * 8 + mi_ < 2) __builtin_amdgcn_global_load_lds((const unsigned*)Hb, (LAS unsigned*)(smem + EX_TAB + 4128), 16, 0, 0); } \
                    else if (ks_ * 8 + mi_ < 12) { asm volatile("s_waitcnt vmcnt(9)" : "+v"(rw[ks_ * 8 + mi_ - 4]) :: "memory"); EX_STORE_W1(ks_ * 8 + mi_ - 4, (s) + 1, nxt_); EX_LOAD_W1(ks_ * 8 + mi_ - 4, t2_); } \
                    __builtin_amdgcn_sched_barrier(0); } } } \
            asm volatile("s_waitcnt vmcnt(8)" ::: "memory"); \
            asm volatile("s_waitcnt lgkmcnt(0)" ::: "memory"); \
            __builtin_amdgcn_s_barrier(); \
            asm volatile("" ::: "memory"); } while (0)
        int s = 0;
#pragma unroll 1
        for (int ps = 0; ps < 2; ++ps) {
#pragma unroll 1
            for (int kt = 0; kt < 16; ++kt, ++s) EX_STEP(s, true, false, s == 31);
            int frg = fr, fqg = fq; asm volatile("" : "+v"(frg), "+v"(fqg));
#pragma unroll
            for (int mi = 0; mi < 8; ++mi) {
                if (mi < nmi) {
                    const int row = (2 * mi + wm) * 16 + frg;
#pragma unroll
                    for (int pr = 0; pr < 2; ++pr) {
                        float g[4];
#pragma unroll
                        for (int j = 0; j < 4; ++j) g[j] = siluf_(acc[mi][2 * pr][j]) * acc[mi][2 * pr + 1][j];
                        uint2 w; w.x = cvt_pk_bf16_f32(g[0], g[1]); w.y = cvt_pk_bf16_f32(g[2], g[3]);
                        *(uint2*)(Gb + (size_t)row * 512 + (ps * 128 + wn * 32 + pr * 16 + 4 * fqg) * 2) = w;
                    }
                }
#pragma unroll
                for (int c = 0; c < 4; ++c) acc[mi][c] = (f32x4){0.f, 0.f, 0.f, 0.f};
            }
        }
#pragma unroll 1
        for (int ps = 0; ps < 4; ++ps) {
#pragma unroll 1
            for (int kt = 0; kt < 4; ++kt, ++s) EX_STEP(s, s < 47, false, true);
            int fro = fr, fqo = fq; asm volatile("" : "+v"(fro), "+v"(fqo));
#pragma unroll
            for (int mi = 0; mi < 8; ++mi) {
                if (mi < nmi) {
                    const int row = (2 * mi + wm) * 16 + fro;
                    const int slot = rowslot[row]; const float w = roww[row];
                    if (slot >= 0) {
#pragma unroll
                        for (int hh = 0; hh < 2; ++hh) {
                            uint4 o;
                            o.x = cvt_pk_bf16_f32(acc[mi][2 * hh][0] * w, acc[mi][2 * hh][1] * w); o.y = cvt_pk_bf16_f32(acc[mi][2 * hh][2] * w, acc[mi][2 * hh][3] * w);
                            o.z = cvt_pk_bf16_f32(acc[mi][2 * hh + 1][0] * w, acc[mi][2 * hh + 1][1] * w); o.w = cvt_pk_bf16_f32(acc[mi][2 * hh + 1][2] * w, acc[mi][2 * hh + 1][3] * w);
                            *(uint4*)(OS + (size_t)slot * 1024 + ps * 256 + wn * 64 + hh * 32 + 8 * fqo) = o;
                        }
                    }
                }
#pragma unroll
                for (int c = 0; c < 4; ++c) acc[mi][c] = (f32x4){0.f, 0.f, 0.f, 0.f};
                asm volatile("" ::: "memory");
            }
        }
        asm volatile("s_waitcnt vmcnt(0)" ::: "memory");
        __syncthreads();
#undef EX_STEP
#undef EX_ISSUE_A1
#undef EX_LOAD_W1
#undef EX_ISSUE_A
#undef EX_LOAD_W
#undef EX_STORE_W
    }
    {
        __syncthreads();
        const int vc = vcu_of(bid, nb), rem = total % nb;
        int G2 = nb, c2 = vc;
        if (rem != 0 && nb - rem >= 32) { G2 = nb - rem; c2 = (total < nb) ? vc - rem : (vc < nb - rem ? vc : -1); }
        if (c2 >= 0) {
            pg8::Gemm g{(const u16*)(p.ws + WS_GSH), (const u16*)(p.ws + WS_WTS2), T, 1024, 256};
            pg8::StaticOrder S; S.init(T, 1024, G2, c2);
            EpiSharedOut E{(u16*)(p.ws + WS_OSLOT)};
            pg8::gemm_phase<EpiSharedOut, pg8::StaticOrder, false, true>((LAS unsigned char*)smem, g, S, E);
        }
    }
}

__device__ __forceinline__ void phase_final(const Params& p, int bid, int nb) {
    const int tid_ = opaque_tid(); const int lane = tid_ & 63, gw = bid * (NT / 64) + (tid_ >> 6), nw = nb * (NT / 64);
    const float* X1 = (const float*)(p.ws + WS_X1); const u16* OS = (const u16*)(p.ws + WS_OSLOT); const float* mod = (const float*)(p.ws + WS_MOD);
    for (int row = gw; row < T; row += nw) {
        const float* gt2 = mod + (row >= SEQ ? 6144 : 0) + 5120;
        float v[16]; float ss = 0.f;
        uint4 wq[2][9]; float4 xq[4];
#pragma unroll
        for (int i = 0; i < 2; ++i) {
            const int col = (i * 64 + lane) * 8;
#pragma unroll
            for (int k = 0; k < 9; ++k) { const size_t srow = (k < 8) ? ((size_t)row * 8 + k) : ((size_t)T * 8 + row); wq[i][k] = *(const uint4*)(OS + srow * 1024 + col); }
            xq[i * 2] = *(const float4*)(X1 + (size_t)row * D + col); xq[i * 2 + 1] = *(const float4*)(X1 + (size_t)row * D + col + 4);
        }
#pragma unroll
        for (int i = 0; i < 2; ++i) {
            const int col = (i * 64 + lane) * 8;
            float a[8] = {0.f, 0.f, 0.f, 0.f, 0.f, 0.f, 0.f, 0.f};
#pragma unroll
            for (int k = 0; k < 9; ++k) {
                const uint4 w = wq[i][k];
                a[0] += bf2f((u16)(w.x & 0xffff)); a[1] += bf2f((u16)(w.x >> 16)); a[2] += bf2f((u16)(w.y & 0xffff)); a[3] += bf2f((u16)(w.y >> 16));
                a[4] += bf2f((u16)(w.z & 0xffff)); a[5] += bf2f((u16)(w.z >> 16)); a[6] += bf2f((u16)(w.w & 0xffff)); a[7] += bf2f((u16)(w.w >> 16));
            }
            const float4 x0 = xq[i * 2], x1v = xq[i * 2 + 1];
            const float4 g0 = *(const float4*)(gt2 + col), g1 = *(const float4*)(gt2 + col + 4);
            v[i * 8 + 0] = x0.x + g0.x * a[0]; v[i * 8 + 1] = x0.y + g0.y * a[1]; v[i * 8 + 2] = x0.z + g0.z * a[2]; v[i * 8 + 3] = x0.w + g0.w * a[3];
            v[i * 8 + 4] = x1v.x + g1.x * a[4]; v[i * 8 + 5] = x1v.y + g1.y * a[5]; v[i * 8 + 6] = x1v.z + g1.z * a[6]; v[i * 8 + 7] = x1v.w + g1.w * a[7];
#pragma unroll
            for (int j = 0; j < 8; ++j) ss += v[i * 8 + j] * v[i * 8 + j];
        }
        ss = wave_sum(ss);
        const float rstd = rsqrtf(ss * (1.0f / D) + 1e-6f);
#pragma unroll
        for (int i = 0; i < 2; ++i) {
            const int col = (i * 64 + lane) * 8;
            const float4 gg0 = *(const float4*)(p.g_final + col), gg1 = *(const float4*)(p.g_final + col + 4);
            float4 o0, o1;
            o0.x = v[i * 8 + 0] * rstd * gg0.x; o0.y = v[i * 8 + 1] * rstd * gg0.y; o0.z = v[i * 8 + 2] * rstd * gg0.z; o0.w = v[i * 8 + 3] * rstd * gg0.w;
            o1.x = v[i * 8 + 4] * rstd * gg1.x; o1.y = v[i * 8 + 5] * rstd * gg1.y; o1.z = v[i * 8 + 6] * rstd * gg1.z; o1.w = v[i * 8 + 7] * rstd * gg1.w;
            *(float4*)(p.out + (size_t)row * D + col) = o0;
            *(float4*)(p.out + (size_t)row * D + col + 4) = o1;
        }
    }
}

constexpr int LDS_BYTES = 73728 + 65536 + 4096;


#define XB_TMO      128
#define XB_XCNT(j)  (256  + 64 * (j))
#define XB_XSUB(j)  (1280 + 64 * (j))
#define XB_XGEN(j)  (2304 + 64 * (j))
#define XB_TOP      3328
#define XB_TOPGEN   3392
#define XCD_BAR_WORDS 3456
#define XB_SPIN_CAP (1u << 18)
__device__ __forceinline__ unsigned xb_ld(unsigned* p)              { return __hip_atomic_load(p, __ATOMIC_RELAXED, __HIP_MEMORY_SCOPE_AGENT); }
__device__ __forceinline__ unsigned xb_add(unsigned* p, unsigned v) { return __hip_atomic_fetch_add(p, v, __ATOMIC_RELAXED, __HIP_MEMORY_SCOPE_AGENT); }
__device__ __forceinline__ unsigned xb_xcc_id() { return (unsigned)__builtin_amdgcn_s_getreg((3 << 11) | 20) & 0xFu; }
#define XB_SPIN(cond, bar) do { unsigned _sp = 0; while (cond) { __builtin_amdgcn_s_sleep(1); \
    if ((++_sp & 255u) == 0u) { if (xb_ld(&(bar)[XB_TMO])) break; if (_sp > XB_SPIN_CAP) { atomicAdd(&(bar)[XB_TMO], 1u); break; } } } } while (0)
struct XcdBarrier { unsigned* bar; unsigned x; volatile LAS unsigned* st; };
__device__ __forceinline__ XcdBarrier xcd_barrier_post(unsigned* bar, volatile LAS unsigned* st) {
    XcdBarrier b; b.bar = bar; b.x = xb_xcc_id(); b.st = st;
    if (threadIdx.x == 0) (void)xb_add(&bar[XB_XCNT(b.x)], 1u);
    return b;
}
__device__ __forceinline__ void xcd_barrier_complete(unsigned* bar, unsigned x, unsigned& nloc, unsigned& nx) {
    const unsigned G = gridDim.x * gridDim.y * gridDim.z;
    unsigned sum, cnt, mine, sp = 0u;
    for (;;) {
        sum = 0u; cnt = 0u; mine = 0u;
#pragma unroll
        for (unsigned j = 0; j < 16; ++j) { const unsigned c = xb_ld(&bar[XB_XCNT(j)]); sum += c; cnt += (c > 0u) ? 1u : 0u; mine = (j == x) ? c : mine; }
        if (sum == G) break;
        __builtin_amdgcn_s_sleep(1);
        if ((++sp & 255u) == 0u) { if (xb_ld(&bar[XB_TMO])) break; if (sp > XB_SPIN_CAP) { atomicAdd(&bar[XB_TMO], 1u); break; } }
    }
    nloc = mine > 0u ? mine : 1u; nx = cnt > 0u ? cnt : 1u;
}
__device__ __forceinline__ void xcd_barrier(const XcdBarrier& b) {
    asm volatile("s_waitcnt vmcnt(0)" ::: "memory");
    __syncthreads();
    if (threadIdx.x == 0) {
        unsigned* bar = b.bar;
        __builtin_amdgcn_s_waitcnt(0);
        unsigned nloc = b.st[0], nx = b.st[1]; const unsigned gen = b.st[2];
        if (nloc == 0u) { xcd_barrier_complete(bar, b.x, nloc, nx); b.st[0] = nloc; b.st[1] = nx; }
        __builtin_amdgcn_fence(__ATOMIC_ACQUIRE, "agent");
        const unsigned old = xb_add(&bar[XB_XSUB(b.x)], 1u);
        if (old + 1u == (gen + 1u) * nloc) {
            __builtin_amdgcn_fence(__ATOMIC_RELEASE, "agent");
            asm volatile("s_waitcnt vmcnt(0)" ::: "memory");
            (void)xb_add(&bar[XB_TOP], 1u);
        }
        const unsigned want = (gen + 1u) * nx;
        XB_SPIN(xb_ld(&bar[XB_TOP]) < want, bar);
        b.st[2] = gen + 1u;
        asm volatile("s_waitcnt vmcnt(0)" ::: "memory");
    }
    __syncthreads();
}

#ifdef DEBUG_CHECK
__device__ __forceinline__ unsigned hash_u(unsigned x) { x ^= x >> 16; x *= 0x7feb352dU; x ^= x >> 15; x *= 0x846ca68bU; x ^= x >> 16; return x; }
__device__ __forceinline__ void phase_check(const Params& p, unsigned char* smem, int bid, int nb) {
    const int lane = threadIdx.x & 63, wid = threadIdx.x >> 6, gw = bid * (NT / 64) + wid, nw = nb * (NT / 64);
    const u16* PROJ = (const u16*)(p.ws + WS_PROJ);
    float* dbg = (float*)(p.ws + WS_CTL + 4096 + 14336);
    float* wsm = (float*)smem + wid * 2048;
    for (int sidx = gw; sidx < 768; sidx += nw) {
        const unsigned hsh = hash_u(sidx * 7919u + 13u);
        int tok = (int)(hsh % T); const int h = (int)((hsh >> 20) & 7);
        if (sidx < 64) tok = (tok & ~(SEQ - 1)) + (int)((hsh >> 8) % 1024);
        const int b = tok / SEQ, t = tok % SEQ, tb = t >> 8;
        wsm[lane] = bf2f(PROJ[(size_t)tok * NPROJ + C_QA + h * 64 + lane]);
        asm volatile("s_waitcnt lgkmcnt(0)" ::: "memory");
        const float qd = wsm[lane];
        float gate = -3e38f;
        if (lane < tb) {
            float g = 0.f;
            for (int r = 0; r < 256; ++r) {
                const u16* kp = PROJ + ((size_t)b * SEQ + lane * 256 + r) * NPROJ + C_KA + h * 64;
                float dsum = 0.f;
                for (int d = 0; d < 64; ++d) dsum += wsm[d] * bf2f(kp[d]);
                g += dsum;
            }
            gate = g * (1.0f / 256.0f);
        }
        const int nsel = tb < 3 ? tb : 3;
        int sel0 = 0, sel1 = 0, sel2 = 0;
        {
            float gg = gate;
            for (int k = 0; k < 3; ++k) {
                float bv = gg; int bi = lane;
                for (int o = 1; o < 64; o <<= 1) { const float ov = __shfl_xor(bv, o); const int oi = __shfl_xor(bi, o); if (ov > bv || (ov == bv && oi < bi)) { bv = ov; bi = oi; } }
                if (k == 0) sel0 = bi; else if (k == 1) sel1 = bi; else sel2 = bi;
                if (lane == bi) gg = -3e38f;
            }
        }
        const float slope = exp2f(-(float)(h + 1));
        float mx = -3e38f, lsum = 0.f, acc = 0.f;
        for (int k = 0; k < 4; ++k) {
            if (k < 3 && k >= nsel) continue;
            const int blk = (k == 0) ? sel0 : (k == 1) ? sel1 : (k == 2) ? sel2 : tb;
            for (int kk = 0; kk < 256; ++kk) {
                const int pos = blk * 256 + kk;
                if (pos > t) break;
                const u16* kp = PROJ + ((size_t)b * SEQ + pos) * NPROJ + C_KA + h * 64;
                const u16* vp = PROJ + ((size_t)b * SEQ + pos) * NPROJ + C_VA + h * 64;
                float sc = wave_sum(qd * bf2f(kp[lane]));
                sc = sc * 0.125f - slope * (float)(t - pos);
                const float mn = fmaxf(mx, sc), f = __expf(mx - mn), e = __expf(sc - mn);
                lsum = lsum * f + e; acc = acc * f + e * bf2f(vp[lane]); mx = mn;
            }
        }
        {
            const float ref = acc / lsum;
            const float got = bf2f(((const u16*)(p.ws + WS_YA))[(size_t)tok * 512 + h * 64 + lane]);
            const float e2 = wave_sum((got - ref) * (got - ref)), r2 = wave_sum(ref * ref);
            if (lane == 0) { atomicAdd(&dbg[0], e2); atomicAdd(&dbg[1], r2); }
        }
    }
    for (int sidx = gw; sidx < 512; sidx += nw) {
        const unsigned hsh = hash_u(sidx * 104729u + 77u);
        const int tok = (int)(hsh % T); const int h = (int)((hsh >> 20) & 7);
        const int b = tok / SEQ, t = tok % SEQ;
        const float l2g = log2_gamma(h);
        for (int d = lane; d < 64; d += 64) wsm[d] = bf2f(PROJ[(size_t)tok * NPROJ + C_QR + h * 64 + d]);
        asm volatile("s_waitcnt lgkmcnt(0)" ::: "memory");
        float o0 = 0.f, o1 = 0.f;
        for (int s0 = 0; s0 <= t; s0 += 64) {
            const int s = s0 + lane; float w = 0.f;
            if (s <= t) {
                const u16* kp = PROJ + ((size_t)b * SEQ + s) * NPROJ + C_KR + h * 64;
                float dsum = 0.f;
                for (int d = 0; d < 64; ++d) dsum += wsm[d] * bf2f(kp[d]);
                w = dsum * exp2f((float)(t - s) * l2g);
            }
            for (int j = 0; j < 64; ++j) {
                const float wj = __shfl(w, j);
                if (s0 + j <= t) {
                    const u16* vp = PROJ + ((size_t)b * SEQ + s0 + j) * NPROJ + C_VR + h * 128;
                    o0 += wj * bf2f(vp[lane]); o1 += wj * bf2f(vp[lane + 64]);
                }
            }
        }
        const float mu = wave_sum(o0 + o1) * (1.0f / 128.0f);
        const float var = wave_sum((o0 - mu) * (o0 - mu) + (o1 - mu) * (o1 - mu)) * (1.0f / 128.0f);
        const float rstd = rsqrtf(var + 1e-6f);
        const u16* GR = PROJ + (size_t)tok * NPROJ + C_GR + h * 128;
        const u16* YR = (const u16*)(p.ws + WS_YR) + (size_t)tok * 1024 + h * 128;
        const float r0 = (o0 - mu) * rstd * bf2f(GR[lane]), r1 = (o1 - mu) * rstd * bf2f(GR[lane + 64]);
        const float g0 = bf2f(YR[lane]), g1 = bf2f(YR[lane + 64]);
        const float e2 = wave_sum((g0 - r0) * (g0 - r0) + (g1 - r1) * (g1 - r1)), r2 = wave_sum(r0 * r0 + r1 * r1);
        if (lane == 0) { atomicAdd(&dbg[2], e2); atomicAdd(&dbg[3], r2); }
    }
}
__device__ __forceinline__ void phase_debug_out(const Params& p, int bid, int nb) {
    const float* dbg = (const float*)(p.ws + WS_CTL + 4096 + 14336);
    const float ea = sqrtf(dbg[0] / fmaxf(dbg[1], 1e-30f)), er = sqrtf(dbg[2] / fmaxf(dbg[3], 1e-30f));
    int la = (int)floorf(-log2f(fmaxf(ea, 1e-9f))); la = la < 0 ? 0 : (la > 8 ? 8 : la); la += 1;
    int lr = (int)floorf(-log2f(fmaxf(er, 1e-9f))); lr = lr < 0 ? 0 : (lr > 8 ? 8 : lr); lr += 1;
    const float c = sqrtf((float)(10 * la + lr - 1));
    for (size_t i = (size_t)bid * NT + threadIdx.x; i < (size_t)T * D; i += (size_t)nb * NT) p.out[i] = c;
}
#endif

__global__ void __launch_bounds__(NT) k_fused(Params p) {
    extern __shared__ __attribute__((aligned(16))) unsigned char smem[];
    const int bid = blockIdx.x, nb = gridDim.x;
    const float* mod = (const float*)(p.ws + WS_MOD);
    volatile LAS unsigned* bst = (volatile LAS unsigned*)(LAS unsigned char*)(smem + LDS_BYTES - 16);
    if (threadIdx.x < 4) bst[threadIdx.x] = 0u;
    __syncthreads();
    const XcdBarrier gbar = xcd_barrier_post((unsigned*)(p.ws + WS_CTL + 4096), bst);
#define GRID_SYNC() xcd_barrier(gbar)
    phase_prologue(p, smem, bid, nb);
    GRID_SYNC();
    phase_norm_mod(p.x, p.g_mix, mod, 0, 1024, (u16*)(p.ws + WS_H), bid, nb);
    GRID_SYNC();
    phase_proj(p, smem, bid, nb);
    GRID_SYNC();
    phase_kmean_kv(p, smem, bid, nb);
    GRID_SYNC();
    phase_gate_scan(p, smem, bid, nb);
    GRID_SYNC();
    phase_attn_ret(p, smem, bid, nb);
    GRID_SYNC();
    phase_combine(p, bid, nb);
    GRID_SYNC();
#ifdef DEBUG_CHECK
    phase_check(p, smem, bid, nb);
    GRID_SYNC();
#endif
    phase_merge(p, smem, bid, nb);
    GRID_SYNC();
    phase_outproj(p, smem, bid, nb);
    GRID_SYNC();
    phase_norm_mod((const float*)(p.ws + WS_X1), p.g_ffn, mod, 3072, 4096, (u16*)(p.ws + WS_H2), bid, nb);
    GRID_SYNC();
    phase_router_gemm(p, smem, bid, nb);
    GRID_SYNC();
    phase_route_shared(p, smem, bid, nb);
    GRID_SYNC();
    phase_experts(p, smem, bid, nb);
    GRID_SYNC();
    phase_final(p, bid, nb);
#ifdef DEBUG_CHECK
    GRID_SYNC();
    phase_debug_out(p, bid, nb);
#endif
}

extern "C" void kernel_launch(void* const* d_in, const int* in_sizes, int n_in, void* d_out, int out_size, void* d_ws, size_t ws_size, hipStream_t stream) {
    static int grid = 0;
    if (grid == 0) {
        int dev = 0, cus = 0, per_cu = 0;
        if (hipGetDevice(&dev) != hipSuccess || hipDeviceGetAttribute(&cus, hipDeviceAttributeMultiprocessorCount, dev) != hipSuccess || cus <= 0) cus = 256;
        (void)hipFuncSetAttribute((const void*)k_fused, hipFuncAttributeMaxDynamicSharedMemorySize, LDS_BYTES);
        if (hipOccupancyMaxActiveBlocksPerMultiprocessor(&per_cu, (const void*)k_fused, NT, LDS_BYTES) != hipSuccess || per_cu < 1) per_cu = 1;
        if (per_cu > 1) per_cu = 1;
        grid = cus * per_cu;
        if (n_in != 19 || out_size != T * D || ws_size < WS_END) { fprintf(stderr, "kernel_launch: unexpected sizes n_in %d out %d ws %zu (need %zu)\n", n_in, out_size, ws_size, (size_t)WS_END); grid = -1; }
    }
    if (grid < 0) return;
    Params p{};
    const float** pp = (const float**)&p;
    for (int i = 0; i < 19; ++i) pp[i] = (const float*)d_in[i];
    p.out = (float*)d_out; p.ws = (unsigned char*)d_ws;
    (void)hipMemsetAsync((char*)d_ws + WS_CTL, 0, CTL_BYTES, stream);
    void* args[] = {&p};
    hipError_t e = hipLaunchCooperativeKernel((const void*)k_fused, dim3(grid), dim3(NT), args, LDS_BYTES, stream);
    if (e != hipSuccess) fprintf(stderr, "cooperative launch failed: %s (grid %d)\n", hipGetErrorString(e), grid);
}
```
